# Optimizing an MI355X kernel written in HIP

```python
import math
import jax, jax.numpy as jnp
from jax import lax
import numpy as np

D_MODEL = 1024
BATCH = 8
SEQ = 2048
DEPTH = 2

CHUNK = 64
Q_BLOCK = 128
ROPE_THETA = 10000.0
LN_EPS = 1e-5
RMS_EPS = 1e-6
DN_ALPHA = (2 * DEPTH) ** 0.25
DN_BETA = (8 * DEPTH) ** -0.25
N_MIXERS = 2
N_MLA = (DEPTH + 1) // 2
N_DSA = DEPTH // 2

MLA_HEADS = 8
MLA_NOPE = 128
MLA_ROPE = 64
MLA_V = 128
MLA_Q_RANK = 384
MLA_KV_RANK = 256
MLA_IN = MLA_Q_RANK + MLA_KV_RANK + MLA_ROPE

DSA_HEADS = 8
DSA_HEAD_DIM = D_MODEL // DSA_HEADS
IDX_HEADS = 8
IDX_DIM = 64
DSA_TOPK_MAX = 256
DSA_HD = DSA_HEADS * DSA_HEAD_DIM
DSA_IN = 3 * DSA_HD + IDX_HEADS * IDX_DIM + IDX_DIM + IDX_HEADS

PEER_HEADS = 8
PEER_NKEYS = 128
PEER_EXPERTS = PEER_NKEYS * PEER_NKEYS
PEER_QDIM = 256
PEER_TOPK = 16
PEER_TOK_BLOCK = 128

kernel_name = "hybrid_mla_dsa_peer_chunk_causal"


def _normal(key, shape, scale):
    return jax.random.normal(key, shape, jnp.float32) * scale


def _layernorm(x, g, b):
    xf = x.astype(jnp.float32)
    mu = jnp.mean(xf, axis=-1, keepdims=True)
    var = jnp.mean(jnp.square(xf - mu), axis=-1, keepdims=True)
    return ((xf - mu) * lax.rsqrt(var + LN_EPS) * g + b).astype(x.dtype)


def _rmsnorm(x, g):
    xf = x.astype(jnp.float32)
    ms = jnp.mean(jnp.square(xf), axis=-1, keepdims=True)
    return (xf * lax.rsqrt(ms + RMS_EPS) * g).astype(x.dtype)


def _rope_tables(seq, dim):
    inv = ROPE_THETA ** (-jnp.arange(0, dim, 2, dtype=jnp.float32) / dim)
    ang = jnp.arange(seq, dtype=jnp.float32)[:, None] * inv[None, :]
    return jnp.cos(ang), jnp.sin(ang)


def _apply_rope(x, cos, sin):
    x1, x2 = jnp.split(x.astype(jnp.float32), 2, axis=-1)
    c = cos[:, None, :]
    s = sin[:, None, :]
    return jnp.concatenate([x1 * c - x2 * s, x2 * c + x1 * s], axis=-1).astype(x.dtype)


def _chunk_causal_attention(q, k, v, scale):
    B, S, H, Dq = q.shape
    nqb = S // Q_BLOCK
    qb = q.reshape(B, nqb, Q_BLOCK, H, Dq).transpose(1, 0, 2, 3, 4)
    key_chunk = jnp.arange(S) // CHUNK

    def one_block(args):
        q_blk, blk = args
        q_chunk = (blk * Q_BLOCK + jnp.arange(Q_BLOCK)) // CHUNK
        s = jnp.einsum('bqhd,bkhd->bhqk', q_blk, k).astype(jnp.float32) * scale
        mask = key_chunk[None, :] <= q_chunk[:, None]
        s = jnp.where(mask[None, None], s, -jnp.inf)
        p = jax.nn.softmax(s, axis=-1).astype(v.dtype)
        return jnp.einsum('bhqk,bkhd->bqhd', p, v)

    out = lax.map(one_block, (qb, jnp.arange(nqb)))
    return out.transpose(1, 0, 2, 3, 4).reshape(B, S, H, v.shape[-1])


def _mla_mixer(x, w_in, q_norm, kv_norm, w_uq, w_ukv, w_o):
    B, S, _ = x.shape
    cos, sin = _rope_tables(S, MLA_ROPE)
    h = x @ w_in
    cq, ckv, k_rope = jnp.split(h, [MLA_Q_RANK, MLA_Q_RANK + MLA_KV_RANK], axis=-1)
    q = jnp.einsum('bsr,rhd->bshd', _rmsnorm(cq, q_norm), w_uq)
    kv = jnp.einsum('bsr,rhd->bshd', _rmsnorm(ckv, kv_norm), w_ukv)
    q_nope, q_rope = jnp.split(q, [MLA_NOPE], axis=-1)
    k_nope, v = jnp.split(kv, [MLA_NOPE], axis=-1)
    q_rope = _apply_rope(q_rope, cos, sin)
    k_rope = _apply_rope(k_rope[:, :, None, :], cos, sin)
    q = jnp.concatenate([q_nope, q_rope], axis=-1)
    k = jnp.concatenate([k_nope, jnp.broadcast_to(k_rope, (B, S, MLA_HEADS, MLA_ROPE))], axis=-1)
    o = _chunk_causal_attention(q, k, v, (MLA_NOPE + MLA_ROPE) ** -0.5)
    return o.reshape(B, S, MLA_HEADS * MLA_V) @ w_o


def _dsa_mixer(x, w_in, w_o):
    B, S, _ = x.shape
    cos_h, sin_h = _rope_tables(S, DSA_HEAD_DIM)
    cos_i, sin_i = _rope_tables(S, IDX_DIM)
    h = x @ w_in
    o1 = 3 * DSA_HD + IDX_HEADS * IDX_DIM
    q, k, v, q_idx, k_idx, w_idx = jnp.split(
        h, [DSA_HD, 2 * DSA_HD, 3 * DSA_HD, o1, o1 + IDX_DIM], axis=-1)
    q = _apply_rope(q.reshape(B, S, DSA_HEADS, DSA_HEAD_DIM), cos_h, sin_h)
    k = _apply_rope(k.reshape(B, S, DSA_HEADS, DSA_HEAD_DIM), cos_h, sin_h)
    v = v.reshape(B, S, DSA_HEADS, DSA_HEAD_DIM)
    q_idx = _apply_rope(q_idx.reshape(B, S, IDX_HEADS, IDX_DIM), cos_i, sin_i)
    k_idx = _apply_rope(k_idx[:, :, None, :], cos_i, sin_i)[:, :, 0, :]
    w_idx = w_idx * (IDX_HEADS ** -0.5 * IDX_DIM ** -0.5)
    topk = min(DSA_TOPK_MAX, S // 4)
    nqb = S // Q_BLOCK
    key_chunk = jnp.arange(S) // CHUNK
    scale = DSA_HEAD_DIM ** -0.5

    def per_batch(args):
        q_b, k_b, v_b, qi_b, ki_b, wi_b = args
        qb = q_b.reshape(nqb, Q_BLOCK, DSA_HEADS, DSA_HEAD_DIM)
        qib = qi_b.reshape(nqb, Q_BLOCK, IDX_HEADS, IDX_DIM)
        wib = wi_b.reshape(nqb, Q_BLOCK, IDX_HEADS)

        def per_block(bargs):
            q_blk, qi_blk, wi_blk, blk = bargs
            q_chunk = (blk * Q_BLOCK + jnp.arange(Q_BLOCK)) // CHUNK
            logits = jnp.einsum('qhd,kd->qhk', qi_blk, ki_b).astype(jnp.float32)
            idx_score = jnp.einsum('qh,qhk->qk', wi_blk.astype(jnp.float32), jax.nn.relu(logits))
            admissible = key_chunk[None, :] <= q_chunk[:, None]
            idx_score = jnp.where(admissible, idx_score, -jnp.inf)
            _, sel = lax.top_k(idx_score, topk)
            k_sel = k_b[sel]
            v_sel = v_b[sel]
            valid = key_chunk[sel] <= q_chunk[:, None]
            s = jnp.einsum('qhd,qkhd->qhk', q_blk, k_sel).astype(jnp.float32) * scale
            s = jnp.where(valid[:, None, :], s, -jnp.inf)
            p = jax.nn.softmax(s, axis=-1).astype(v_sel.dtype)
            return jnp.einsum('qhk,qkhd->qhd', p, v_sel)

        ob = lax.map(per_block, (qb, qib, wib, jnp.arange(nqb)))
        return ob.reshape(S, DSA_HD)

    o = lax.map(per_batch, (q, k, v, q_idx, k_idx, w_idx))
    return o @ w_o


def _peer(x, w_q, sub_keys, w_down, w_up):
    B, S, D = x.shape
    T = B * S
    xt = x.reshape(T, D)
    q = (xt @ w_q).reshape(T, PEER_HEADS, 2, PEER_QDIM // 2)
    s1 = jnp.einsum('thd,hnd->thn', q[:, :, 0], sub_keys[0]).astype(jnp.float32)
    s2 = jnp.einsum('thd,hnd->thn', q[:, :, 1], sub_keys[1]).astype(jnp.float32)
    v1, i1 = lax.top_k(s1, PEER_TOPK)
    v2, i2 = lax.top_k(s2, PEER_TOPK)
    cand = (v1[..., :, None] + v2[..., None, :]).reshape(T, PEER_HEADS, PEER_TOPK * PEER_TOPK)
    cand_idx = (i1[..., :, None] * PEER_NKEYS + i2[..., None, :]).reshape(
        T, PEER_HEADS, PEER_TOPK * PEER_TOPK)
    best, pos = lax.top_k(cand, PEER_TOPK)
    expert = jnp.take_along_axis(cand_idx, pos, axis=-1)
    gate = jax.nn.softmax(best, axis=-1)
    n_e = PEER_HEADS * PEER_TOPK
    nb = T // PEER_TOK_BLOCK
    xb = xt.reshape(nb, PEER_TOK_BLOCK, D)
    eb = expert.reshape(nb, PEER_TOK_BLOCK, n_e)
    gb = gate.reshape(nb, PEER_TOK_BLOCK, n_e)

    def per_block(args):
        x_blk, e_blk, g_blk = args
        u = w_down[e_blk]
        a = jnp.einsum('td,ted->te', x_blk, u).astype(jnp.float32)
        hg = (jax.nn.gelu(a, approximate=False) * g_blk).astype(w_up.dtype)
        return jnp.einsum('te,ted->td', hg, w_up[e_blk]).astype(x_blk.dtype)

    y = lax.map(per_block, (xb, eb, gb))
    return y.reshape(B, S, D)


def setup_inputs(seed: int = 0) -> dict:
    key = jax.random.key(seed)
    ks = jax.random.split(key, 20)
    D = D_MODEL
    return {
        "x": _normal(ks[0], (BATCH, SEQ, D), 1.0),
        "mla_w_in": _normal(ks[1], (N_MLA, D, MLA_IN), D ** -0.5),
        "mla_q_norm": 1.0 + _normal(ks[2], (N_MLA, MLA_Q_RANK), 0.02),
        "mla_kv_norm": 1.0 + _normal(ks[3], (N_MLA, MLA_KV_RANK), 0.02),
        "mla_w_uq": _normal(ks[4], (N_MLA, MLA_Q_RANK, MLA_HEADS, MLA_NOPE + MLA_ROPE), MLA_Q_RANK ** -0.5),
        "mla_w_ukv": _normal(ks[5], (N_MLA, MLA_KV_RANK, MLA_HEADS, MLA_NOPE + MLA_V), MLA_KV_RANK ** -0.5),
        "mla_w_o": _normal(ks[6], (N_MLA, MLA_HEADS * MLA_V, D), DN_BETA * (MLA_HEADS * MLA_V) ** -0.5),
        "dsa_w_in": _normal(ks[7], (N_DSA, D, DSA_IN), D ** -0.5),
        "dsa_w_o": _normal(ks[8], (N_DSA, DSA_HD, D), DN_BETA * DSA_HD ** -0.5),
        "peer_w_q": _normal(ks[9], (DEPTH, D, PEER_HEADS * PEER_QDIM), D ** -0.5),
        "peer_sub_keys": _normal(ks[10], (DEPTH, 2, PEER_HEADS, PEER_NKEYS, PEER_QDIM // 2), (PEER_QDIM // 2) ** -0.5),
        "peer_w_down": _normal(ks[11], (DEPTH, PEER_EXPERTS, D), D ** -0.5),
        "peer_w_up": _normal(ks[12], (DEPTH, PEER_EXPERTS, D), DN_BETA * PEER_HEADS ** -0.5),
        "ln_gain": 1.0 + _normal(ks[13], (DEPTH, 2, D), 0.02),
        "ln_bias": _normal(ks[14], (DEPTH, 2, D), 0.02),
    }


def reference(x, mla_w_in, mla_q_norm, mla_kv_norm, mla_w_uq, mla_w_ukv, mla_w_o,
              dsa_w_in, dsa_w_o, peer_w_q, peer_sub_keys, peer_w_down, peer_w_up,
              ln_gain, ln_bias):
    for i in range(DEPTH):
        j = i // N_MIXERS
        if i % N_MIXERS == 0:
            m = _mla_mixer(x, mla_w_in[j], mla_q_norm[j], mla_kv_norm[j],
                           mla_w_uq[j], mla_w_ukv[j], mla_w_o[j])
        else:
            m = _dsa_mixer(x, dsa_w_in[j], dsa_w_o[j])
        x = _layernorm(DN_ALPHA * x + m, ln_gain[i, 0], ln_bias[i, 0])
        f = _peer(x, peer_w_q[i], peer_sub_keys[i], peer_w_down[i], peer_w_up[i])
        x = _layernorm(DN_ALPHA * x + f, ln_gain[i, 1], ln_bias[i, 1])
    return x
```

```cpp
#include <hip/hip_runtime.h>
#include <hip/hip_cooperative_groups.h>
#include <cstdio>
#include <cmath>
#include <cstring>
namespace cg = cooperative_groups;

#define DI __device__ __forceinline__
typedef __attribute__((ext_vector_type(8))) short bf16x8;
typedef __attribute__((ext_vector_type(4))) short s16x4;
typedef __attribute__((ext_vector_type(16))) float f32x16;
typedef __attribute__((ext_vector_type(2))) __bf16 bf2;
typedef __attribute__((ext_vector_type(2))) float f2;
typedef unsigned short bf16;
typedef unsigned int u32;
typedef unsigned long long u64;
typedef __attribute__((ext_vector_type(4))) u32 u32x4;

#define MFMA(a, b, c) __builtin_amdgcn_mfma_f32_32x32x16_bf16((a), (b), (c), 0, 0, 0)

constexpr int T_TOK = 16384;
constexpr int SEQ = 2048;
constexpr float DN_ALPHA = 1.4142135623730951f;
constexpr size_t MB = 1ull << 20;

constexpr size_t OFF_WDOWN = 0;
constexpr size_t OFF_WUP   = 64 * MB;
constexpr size_t OFF_X2F   = 128 * MB;
constexpr size_t OFF_XB    = 192 * MB;
constexpr size_t OFF_VT    = 224 * MB;
constexpr size_t OFF_Q     = 256 * MB;
constexpr size_t OFF_K     = 304 * MB;
constexpr size_t OFF_M     = 256 * MB;
constexpr size_t OFF_HB    = 352 * MB;
constexpr size_t OFF_MASK  = 372 * MB;
constexpr size_t OFF_EX    = 376 * MB;
constexpr size_t OFF_GT    = 384 * MB;
constexpr size_t OFF_HGP   = 440 * MB;
constexpr size_t OFF_CTR   = 448 * MB;
constexpr size_t OFF_RSD   = 450 * MB;
constexpr size_t OFF_RSU   = 451 * MB;
constexpr size_t OFF_SD    = 452 * MB;
constexpr size_t OFF_RSS   = 460 * MB;
constexpr size_t OFF_BAR   = 449 * MB;
constexpr size_t OFF_YB    = 256 * MB;
constexpr size_t OFF_QI    = 392 * MB;
constexpr size_t OFF_KI    = 408 * MB;
constexpr size_t OFF_WI    = 410 * MB;
constexpr size_t OFF_WTS   = 411 * MB;
constexpr size_t OFF_WIN_T  = OFF_WTS;
constexpr size_t OFF_WUQ_T  = OFF_WIN_T + 768 * 1024 * 2;
constexpr size_t OFF_WUKV_T = OFF_WUQ_T + 1536 * 384 * 2;
constexpr size_t OFF_WO_T   = OFF_WUKV_T + 2048 * 256 * 2;
constexpr size_t OFF_DIN_T  = OFF_WO_T + 1024 * 1024 * 2;
constexpr size_t OFF_DO_T   = OFF_DIN_T + 3712 * 1024 * 2;
constexpr size_t OFF_WQ_T   = OFF_DO_T + 1024 * 1024 * 2;
constexpr size_t OFF_SUBK   = OFF_WQ_T + 2 * 2048 * 1024 * 2;
constexpr size_t OFF_TAB64  = OFF_SUBK + 524288 * 2;
constexpr size_t OFF_TAB128 = OFF_TAB64 + 2048 * 32 * 8;

struct Params {
  const float *x, *mla_w_in, *mla_q_norm, *mla_kv_norm, *mla_w_uq, *mla_w_ukv, *mla_w_o, *dsa_w_in, *dsa_w_o,
      *peer_w_q, *peer_sub_keys, *peer_w_down, *peer_w_up, *ln_gain, *ln_bias;
  float* out;
  unsigned char* ws;
  float inv64[32];
  float inv128[64];
};

constexpr int SCROW = 2112;
constexpr int SMEM_BYTES = 8 * SCROW * 4;
#ifndef PH
#define PH 0xFFFFF
#endif
#ifndef REPM
#define REPM 0
#endif
#define RUN(k, ...) if (PH & (1 << k)) { __VA_ARGS__; if (REPM & (1 << k)) { xcd_barrier(gbar); __VA_ARGS__; } }

DI u32 pack2(float a, float b) {
  f2 v = {a, b};
  bf2 r = __builtin_convertvector(v, bf2);
  return __builtin_bit_cast(u32, r);
}
DI bf16 f2bf(float a) { return (bf16)(pack2(a, 0.f) & 0xffffu); }
DI float bflo(u32 u) { return __uint_as_float(u << 16); }
DI float bfhi(u32 u) { return __uint_as_float(u & 0xffff0000u); }
DI u32 sortable(float f) { u32 u = __float_as_uint(f); return u ^ ((u >> 31) ? 0xFFFFFFFFu : 0x80000000u); }
DI float unsortable(u32 k) { u32 u = k ^ ((k >> 31) ? 0x80000000u : 0xFFFFFFFFu); return __uint_as_float(u); }
DI int crow(int i, int g) { return (i & 3) + 8 * (i >> 2) + 4 * g; }
DI float wave_sum(float v) {
  v += __shfl_xor(v, 32); v += __shfl_xor(v, 16); v += __shfl_xor(v, 8);
  v += __shfl_xor(v, 4); v += __shfl_xor(v, 2); v += __shfl_xor(v, 1);
  return v;
}
DI int opaque_tid() { int t = threadIdx.x; asm volatile("" : "+v"(t)); return t; }
DI int wave_sum_i(int v) {
  v += __shfl_xor(v, 32); v += __shfl_xor(v, 16); v += __shfl_xor(v, 8);
  v += __shfl_xor(v, 4); v += __shfl_xor(v, 2); v += __shfl_xor(v, 1);
  return v;
}
DI void cnt_ge_u(int& cnt, u32 a, u32 b) { asm("v_cmp_ge_u32 vcc, %1, %2\n\tv_addc_co_u32 %0, vcc, 0, %0, vcc" : "+v"(cnt) : "v"(a), "v"(b) : "vcc"); }
DI int ballot_cnt_ge(u32 a, u32 b) {
  int t;
  asm volatile("v_cmp_ge_u32 vcc, %1, %2\n\ts_bcnt1_i32_b64 %0, vcc" : "=s"(t) : "v"(a), "v"(b) : "vcc", "scc");
  return t;
}
template <int NJ>
DI u32 bisect256(const u32* row, int lane, int nw, int& cge) {
  u32 v[NJ];
#pragma unroll
  for (int j = 0; j < NJ; ++j) v[j] = (j < nw) ? row[j * 66 + lane + (lane >> 5)] : 0u;
  u32 Tt = 0u;
  for (int bit = 31; bit >= 0; --bit) {
    const u32 cand = Tt | (1u << bit);
    int cnt = 0;
#pragma unroll
    for (int j = 0; j < NJ; ++j) cnt += ballot_cnt_ge(v[j], cand);
    if (cnt >= 256) Tt = cand;
  }
  cge = 0;
#pragma unroll
  for (int j = 0; j < NJ; ++j) cge += ballot_cnt_ge(v[j], Tt);
  return Tt;
}
DI int cmp_ge_u(u32 a, u32 b) { int r; asm("v_cmp_ge_u32 vcc, %1, %2\n\tv_cndmask_b32 %0, 0, 1, vcc" : "=v"(r) : "v"(a), "v"(b) : "vcc"); return r; }
DI int cmp_gt_u(u32 a, u32 b) { int r; asm("v_cmp_gt_u32 vcc, %1, %2\n\tv_cndmask_b32 %0, 0, 1, vcc" : "=v"(r) : "v"(a), "v"(b) : "vcc"); return r; }
DI int cmp_eq_u(u32 a, u32 b) { int r; asm("v_cmp_eq_u32 vcc, %1, %2\n\tv_cndmask_b32 %0, 0, 1, vcc" : "=v"(r) : "v"(a), "v"(b) : "vcc"); return r; }
DI void ins16(u32 (&L)[16], u32 v) {
#pragma unroll
  for (int j = 0; j < 16; ++j) { u32 hi = max(L[j], v); v = min(L[j], v); L[j] = hi; }
}

DI void sincos_d(float angf, float& c, float& s) {
  double x = (double)angf;
  double n = __builtin_rint(x * 0.63661977236758134);
  double rr = __builtin_fma(-n, 1.5707963267948966, x);
  rr = __builtin_fma(-n, 6.123233995736766e-17, rr);
  int q = ((int)n) & 3;
  double r2 = rr * rr;
  double sp = rr * (1.0 + r2 * (-1.0 / 6 + r2 * (1.0 / 120 + r2 * (-1.0 / 5040 + r2 * (1.0 / 362880 + r2 * (-1.0 / 39916800 + r2 * (1.0 / 6227020800.0)))))));
  double cp = 1.0 + r2 * (-0.5 + r2 * (1.0 / 24 + r2 * (-1.0 / 720 + r2 * (1.0 / 40320 + r2 * (-1.0 / 3628800 + r2 * (1.0 / 479001600 + r2 * (-1.0 / 87178291200.0)))))));
  float sf = (float)sp, cf = (float)cp;
  if (q == 0) { c = cf; s = sf; }
  else if (q == 1) { c = -sf; s = cf; }
  else if (q == 2) { c = -cf; s = -sf; }
  else { c = sf; s = -cf; }
}

#define XB_TMO      128
#define XB_XCNT(j)  (256  + 64 * (j))
#define XB_XSUB(j)  (1280 + 64 * (j))
#define XB_XGEN(j)  (2304 + 64 * (j))
#define XB_TOP      3328
#define XB_TOPGEN   3392
#define XCD_BAR_WORDS 3456
#define XB_SPIN_CAP (1u << 20)
#define LAS __attribute__((address_space(3)))
DI unsigned xb_ld(unsigned* p)              { return __hip_atomic_load(p, __ATOMIC_RELAXED, __HIP_MEMORY_SCOPE_AGENT); }
DI unsigned xb_add(unsigned* p, unsigned v) { return __hip_atomic_fetch_add(p, v, __ATOMIC_RELAXED, __HIP_MEMORY_SCOPE_AGENT); }
DI unsigned xb_xcc_id() { return (unsigned)__builtin_amdgcn_s_getreg((3 << 11) | 20) & 0xFu; }
#define XB_SPIN(cond, bar) do { unsigned _sp = 0; while (cond) { __builtin_amdgcn_s_sleep(1); \
    if ((++_sp & 255u) == 0u) { if (xb_ld(&(bar)[XB_TMO])) break; if (_sp > XB_SPIN_CAP) { atomicAdd(&(bar)[XB_TMO], 1u); break; } } } } while (0)
struct XcdBarrier { unsigned* bar; unsigned x; volatile LAS unsigned* st; };
DI XcdBarrier xcd_barrier_post(unsigned* bar, volatile LAS unsigned* st) {
  XcdBarrier b; b.bar = bar; b.x = xb_xcc_id(); b.st = st;
  if (threadIdx.x == 0) (void)xb_add(&bar[XB_XCNT(b.x)], 1u);
  return b;
}
DI void xcd_barrier_complete(unsigned* bar, unsigned x, unsigned& nloc, unsigned& nx) {
  const unsigned G = gridDim.x * gridDim.y * gridDim.z;
  unsigned sum, cnt, mine, sp = 0u;
  for (;;) {
    sum = 0u; cnt = 0u; mine = 0u;
#pragma unroll
    for (unsigned j = 0; j < 16; ++j) { const unsigned c = xb_ld(&bar[XB_XCNT(j)]); sum += c; cnt += (c > 0u) ? 1u : 0u; mine = (j == x) ? c : mine; }
    if (sum == G) break;
    __builtin_amdgcn_s_sleep(1);
    if ((++sp & 255u) == 0u) { if (xb_ld(&bar[XB_TMO])) break; if (sp > XB_SPIN_CAP) { atomicAdd(&bar[XB_TMO], 1u); break; } }
  }
  nloc = mine > 0u ? mine : 1u; nx = cnt > 0u ? cnt : 1u;
}
DI void xcd_barrier(const XcdBarrier& b) {
  asm volatile("s_waitcnt vmcnt(0)" ::: "memory");
  __syncthreads();
  if (threadIdx.x == 0) {
    unsigned* bar = b.bar;
    __builtin_amdgcn_s_waitcnt(0);
    unsigned nloc = b.st[0], nx = b.st[1];
    if (nloc == 0u) { xcd_barrier_complete(bar, b.x, nloc, nx); b.st[0] = nloc; b.st[1] = nx; }
    const unsigned old = xb_add(&bar[XB_XSUB(b.x)], 1u);
    const unsigned gen = old / nloc;
    if (old + 1u == (gen + 1u) * nloc) {
      __builtin_amdgcn_fence(__ATOMIC_RELEASE, "agent");
      asm volatile("s_waitcnt vmcnt(0)" ::: "memory");
      const unsigned og = xb_add(&bar[XB_TOP], 1u);
      const unsigned tg = og / nx;
      if (og + 1u == (tg + 1u) * nx) xb_add(&bar[XB_TOPGEN], 1u);
      else XB_SPIN(xb_ld(&bar[XB_TOPGEN]) == tg, bar);
      __builtin_amdgcn_fence(__ATOMIC_ACQUIRE, "agent");
      xb_add(&bar[XB_XGEN(b.x)], 1u);
      asm volatile("s_waitcnt vmcnt(0)" ::: "memory");
    } else {
      XB_SPIN(xb_ld(&bar[XB_XGEN(b.x)]) == gen, bar);
      __builtin_amdgcn_fence(__ATOMIC_ACQUIRE, "agent");
      asm volatile("s_waitcnt vmcnt(0)" ::: "memory");
    }
  }
  __syncthreads();
}

DI void convert_job(const float* __restrict__ src, bf16* __restrict__ dst, size_t n) {
  size_t n4 = n >> 2;
  for (size_t i = (size_t)blockIdx.x * 256 + threadIdx.x; i < n4; i += (size_t)gridDim.x * 256) {
    float4 v = ((const float4*)src)[i];
    uint2 o; o.x = pack2(v.x, v.y); o.y = pack2(v.z, v.w);
    ((uint2*)dst)[i] = o;
  }
}

DI void fp8_rows(const float* __restrict__ src, unsigned char* __restrict__ dst, float* __restrict__ rs, int nrows) {
  const int lane = threadIdx.x & 63, w = threadIdx.x >> 6;
  for (int row = blockIdx.x * 4 + w; row < nrows; row += gridDim.x * 4) {
    float4 v[4];
    float am = 0.f;
#pragma unroll
    for (int i = 0; i < 4; ++i) {
      v[i] = *(const float4*)(src + (size_t)row * 1024 + 4 * lane + 256 * i);
      am = fmaxf(am, fmaxf(fmaxf(fabsf(v[i].x), fabsf(v[i].y)), fmaxf(fabsf(v[i].z), fabsf(v[i].w))));
    }
    am = fmaxf(am, __shfl_xor(am, 32)); am = fmaxf(am, __shfl_xor(am, 16)); am = fmaxf(am, __shfl_xor(am, 8));
    am = fmaxf(am, __shfl_xor(am, 4)); am = fmaxf(am, __shfl_xor(am, 2)); am = fmaxf(am, __shfl_xor(am, 1));
    const float sc = am > 0.f ? 440.f / am : 1.f;
    if (lane == 0) rs[row] = am > 0.f ? am / 440.f : 1.f;
#pragma unroll
    for (int i = 0; i < 4; ++i) {
      int pk = __builtin_amdgcn_cvt_pk_fp8_f32(v[i].x * sc, v[i].y * sc, 0, false);
      pk = __builtin_amdgcn_cvt_pk_fp8_f32(v[i].z * sc, v[i].w * sc, pk, true);
      *(int*)(dst + (size_t)row * 1024 + 4 * lane + 256 * i) = pk;
    }
  }
}

DI void transpose_job(const float* __restrict__ src, int K, int N, int Npad, bf16* __restrict__ dst, const float* __restrict__ gain, float* tile) {
  const int tid = opaque_tid();
  const int kt_n = K / 64, nt_n = Npad / 64;
  for (int t = blockIdx.x; t < kt_n * nt_n; t += gridDim.x) {
    const int kt = t % kt_n, nt = t / kt_n;
    __syncthreads();
#pragma unroll
    for (int i = 0; i < 4; ++i) {
      int k = (tid >> 4) + 16 * i;
      int n = nt * 64 + (tid & 15) * 4;
      float4 v = make_float4(0.f, 0.f, 0.f, 0.f);
      if (n < N) v = *(const float4*)(src + (size_t)(kt * 64 + k) * N + n);
      float gn = gain ? gain[kt * 64 + k] : 1.f;
      float* tp = tile + k * 65 + (tid & 15) * 4;
      tp[0] = v.x * gn; tp[1] = v.y * gn; tp[2] = v.z * gn; tp[3] = v.w * gn;
    }
    __syncthreads();
#pragma unroll
    for (int i = 0; i < 2; ++i) {
      int n = (tid >> 3) + 32 * i;
      int kc = (tid & 7) * 8;
      float f[8];
#pragma unroll
      for (int j = 0; j < 8; ++j) f[j] = tile[(kc + j) * 65 + n];
      uint4 o; o.x = pack2(f[0], f[1]); o.y = pack2(f[2], f[3]); o.z = pack2(f[4], f[5]); o.w = pack2(f[6], f[7]);
      *(uint4*)(dst + (size_t)(nt * 64 + n) * K + kt * 64 + kc) = o;
    }
  }
}

DI void prep_phase(const Params& p, unsigned char* smem) {
  unsigned char* ws = p.ws;
  float* tile = (float*)smem;
  convert_job(p.x, (bf16*)(ws + OFF_XB), (size_t)T_TOK * 1024);
  convert_job(p.peer_sub_keys, (bf16*)(ws + OFF_SUBK), 524288);
  transpose_job(p.mla_w_in, 1024, 704, 768, (bf16*)(ws + OFF_WIN_T), nullptr, tile);
  transpose_job(p.mla_w_uq, 384, 1536, 1536, (bf16*)(ws + OFF_WUQ_T), p.mla_q_norm, tile);
  transpose_job(p.mla_w_ukv, 256, 2048, 2048, (bf16*)(ws + OFF_WUKV_T), p.mla_kv_norm, tile);
  transpose_job(p.mla_w_o, 1024, 1024, 1024, (bf16*)(ws + OFF_WO_T), nullptr, tile);
  transpose_job(p.dsa_w_in, 1024, 3656, 3712, (bf16*)(ws + OFF_DIN_T), nullptr, tile);
  transpose_job(p.dsa_w_o, 1024, 1024, 1024, (bf16*)(ws + OFF_DO_T), nullptr, tile);
  transpose_job(p.peer_w_q, 1024, 2048, 2048, (bf16*)(ws + OFF_WQ_T), nullptr, tile);
  transpose_job(p.peer_w_q + (size_t)1024 * 2048, 1024, 2048, 2048, (bf16*)(ws + OFF_WQ_T) + (size_t)2048 * 1024, nullptr, tile);
  if (blockIdx.x == 0) ((u32*)(ws + OFF_CTR))[threadIdx.x] = 0u;
  float2* t64 = (float2*)(ws + OFF_TAB64);
  float2* t128 = (float2*)(ws + OFF_TAB128);
  for (int i = blockIdx.x * 256 + threadIdx.x; i < 2048 * 96; i += gridDim.x * 256) {
    int pos = i / 96, f = i % 96;
    float inv = f < 32 ? p.inv64[f] : p.inv128[f - 32];
    float ang = (float)pos * inv;
    float c, s;
    sincos_d(ang, c, s);
    if (f < 32) t64[pos * 32 + f] = make_float2(c, s);
    else t128[pos * 64 + (f - 32)] = make_float2(c, s);
  }
}

constexpr int LDT = 72;

struct GTile { u32x4 a0, a1, a2, a3, b0, b1, b2, b3; };
DI void gt_load(GTile& t, const bf16* ap, const bf16* bp, int lda, int ldb, int k) {
  const bf16* a2 = ap + k;
  const bf16* b2 = bp + k;
  t.a0 = *(const u32x4*)(a2); t.a1 = *(const u32x4*)(a2 + (size_t)32 * lda); t.a2 = *(const u32x4*)(a2 + (size_t)64 * lda); t.a3 = *(const u32x4*)(a2 + (size_t)96 * lda);
  t.b0 = *(const u32x4*)(b2); t.b1 = *(const u32x4*)(b2 + (size_t)32 * ldb); t.b2 = *(const u32x4*)(b2 + (size_t)64 * ldb); t.b3 = *(const u32x4*)(b2 + (size_t)96 * ldb);
}
DI void gt_store(const GTile& t, bf16* asw, bf16* bsw) {
  *(u32x4*)(asw) = t.a0; *(u32x4*)(asw + 32 * LDT) = t.a1; *(u32x4*)(asw + 64 * LDT) = t.a2; *(u32x4*)(asw + 96 * LDT) = t.a3;
  *(u32x4*)(bsw) = t.b0; *(u32x4*)(bsw + 32 * LDT) = t.b1; *(u32x4*)(bsw + 64 * LDT) = t.b2; *(u32x4*)(bsw + 96 * LDT) = t.b3;
}
DI void gt_compute(const bf16* asr, const bf16* bsr, f32x16& acc0, f32x16& acc1, f32x16& acc2, f32x16& acc3) {
  bf16x8 a[4], b0[4], b1[4], b2[4], b3[4];
#pragma unroll
  for (int kk = 0; kk < 4; ++kk) {
    a[kk] = *(const bf16x8*)(asr + kk * 16);
    b0[kk] = *(const bf16x8*)(bsr + kk * 16);
    b1[kk] = *(const bf16x8*)(bsr + 32 * LDT + kk * 16);
    b2[kk] = *(const bf16x8*)(bsr + 64 * LDT + kk * 16);
    b3[kk] = *(const bf16x8*)(bsr + 96 * LDT + kk * 16);
  }
  __builtin_amdgcn_sched_barrier(0);
  __builtin_amdgcn_s_setprio(2);
#pragma unroll
  for (int kk = 0; kk < 4; ++kk) {
    acc0 = MFMA(a[kk], b0[kk], acc0); acc1 = MFMA(a[kk], b1[kk], acc1); acc2 = MFMA(a[kk], b2[kk], acc2); acc3 = MFMA(a[kk], b3[kk], acc3);
  }
  __builtin_amdgcn_s_setprio(0);
  __builtin_amdgcn_sched_barrier(0);
}
DI void gemm_mainloop(const bf16* __restrict__ A, int lda, const bf16* __restrict__ Bt, int ldb, int K, int m0, int n0,
                      bf16* As, bf16* Bs, f32x16& acc0, f32x16& acc1, f32x16& acc2, f32x16& acc3) {
  const int tid = opaque_tid(), lane = tid & 63, w = tid >> 6, r = lane & 31, g = lane >> 5;
  const int lrow = tid >> 3, lcc = (tid & 7) * 8;
  const bf16* ap = A + (size_t)(m0 + lrow) * lda + lcc;
  const bf16* bp = Bt + (size_t)(n0 + lrow) * ldb + lcc;
  GTile t0, t1;
  asm volatile("" ::: "memory");
  const int nkt = K >> 6;
  int kb = ((((m0 >> 7) * 5 + (n0 >> 7) * 3) >> 1) % nkt) << 6;
#define KW(off) ((kb + (off)) >= K ? (kb + (off)) - K : (kb + (off)))
  gt_load(t0, ap, bp, lda, ldb, KW(0));
  gt_load(t1, ap, bp, lda, ldb, KW(64));
#pragma unroll
  for (int i = 0; i < 16; ++i) { acc0[i] = 0.f; acc1[i] = 0.f; acc2[i] = 0.f; acc3[i] = 0.f; }
  bf16* asw = As + lrow * LDT + lcc;
  bf16* bsw = Bs + lrow * LDT + lcc;
  const bf16* asr = As + (32 * w + r) * LDT + g * 8;
  const bf16* bsr = Bs + r * LDT + g * 8;
  for (int k0 = 0; k0 < K; k0 += 128) {
    __syncthreads();
    gt_store(t0, asw, bsw);
    __syncthreads();
    if (k0 + 128 < K) gt_load(t0, ap, bp, lda, ldb, KW(k0 + 128));
    gt_compute(asr, bsr, acc0, acc1, acc2, acc3);
    __syncthreads();
    gt_store(t1, asw, bsw);
    __syncthreads();
    if (k0 + 192 < K) gt_load(t1, ap, bp, lda, ldb, KW(k0 + 192));
    gt_compute(asr, bsr, acc0, acc1, acc2, acc3);
  }
#undef KW
}

DI void row_rms(const bf16* __restrict__ A, int lda, int kc, int m0, float* rs) {
  const int tid = opaque_tid(), lane = tid & 63, w = tid >> 6, r = lane & 31, g = lane >> 5;
  for (int it = 0; it < 16; ++it) {
    int row = 32 * w + 2 * it + g;
    const bf16* rp = A + (size_t)(m0 + row) * lda;
    float ss = 0.f;
    for (int c = r; c < kc / 8; c += 32) {
      uint4 v = *(const uint4*)(rp + c * 8);
      float a0 = bflo(v.x), a1 = bfhi(v.x), a2 = bflo(v.y), a3 = bfhi(v.y), a4 = bflo(v.z), a5 = bfhi(v.z), a6 = bflo(v.w), a7 = bfhi(v.w);
      ss += a0 * a0 + a1 * a1 + a2 * a2 + a3 * a3 + a4 * a4 + a5 * a5 + a6 * a6 + a7 * a7;
    }
    ss += __shfl_xor(ss, 16); ss += __shfl_xor(ss, 8); ss += __shfl_xor(ss, 4); ss += __shfl_xor(ss, 2); ss += __shfl_xor(ss, 1);
    if (r == 0) rs[row] = rsqrtf(ss / (float)kc + 1e-6f);
  }
}

enum { EPI_MLA_IN = 0, EPI_MLA_Q, EPI_MLA_KV, EPI_F32, EPI_PEER, EPI_DSA_IN };

template <int EPI, int HOT = 0>
DI void gemm_phase(const Params& p, unsigned char* smem, const bf16* __restrict__ A, int lda, const bf16* __restrict__ Bt, int K, int Ntiles, int layer) {
  unsigned char* ws = p.ws;
  bf16* As = (bf16*)smem;
  bf16* Bs = As + 128 * LDT;
  float* rs = (float*)(smem + 40960);
  const int tid = opaque_tid(), lane = tid & 63, w = tid >> 6, r = lane & 31, g = lane >> 5;
  const int ntot = 128 * Ntiles;
  int t_start = blockIdx.x, t_step = gridDim.x, t_total = ntot, cntS = 0, xi = 0;
  if constexpr (EPI == EPI_DSA_IN) {
    int* sl = (int*)(smem + 40960);
    __syncthreads();
    if (tid == 0) {
      unsigned* bar = (unsigned*)(ws + OFF_BAR);
      const unsigned myx = xb_xcc_id();
      int nx = 0, xo = 0, nloc = 1;
      for (unsigned j = 0; j < 16; ++j) { const unsigned cj = xb_ld(&bar[XB_XCNT(j)]); if (cj > 0u) { if (j == myx) { xo = nx; nloc = (int)cj; } ++nx; } }
      sl[0] = (int)atomicAdd((u32*)(ws + OFF_CTR) + 128 + myx, 1u);
      sl[1] = nloc; sl[2] = xo; sl[3] = nx;
    }
    __syncthreads();
    if (sl[3] == 8) {
      xi = sl[2];
      cntS = (Ntiles - 1 - xi) / 8 + 1;
      t_start = sl[0]; t_step = sl[1]; t_total = 128 * cntS;
    }
    __syncthreads();
  }
  for (int tile = t_start; tile < t_total; tile += t_step) {
    int mt, nt;
    if (cntS) { mt = tile / cntS; nt = xi + 8 * (tile % cntS); } else { mt = tile / Ntiles; nt = tile % Ntiles; }
    const int m0 = mt * 128, n0 = nt * 128;
    if (EPI == EPI_MLA_Q || EPI == EPI_MLA_KV) {
      __syncthreads();
      if (tid < 128) {
        const float* rp = (const float*)(ws + OFF_RSS) + (size_t)(m0 + tid) * 8;
        const float ssq = (EPI == EPI_MLA_Q) ? ((rp[0] + rp[1]) + rp[2]) : (rp[3] + rp[4]);
        rs[tid] = rsqrtf(ssq / (float)K + 1e-6f);
      }
    }
    f32x16 acc[4];
    gemm_mainloop(A, lda, Bt, K, K, m0, n0, As, Bs, acc[0], acc[1], acc[2], acc[3]);
    if (HOT && acc[0][0] + acc[1][1] + acc[2][2] + acc[3][3] != 12345.678f) continue;
    const int bidx = m0 >> 11;
    const int s0 = (m0 & 2047) + 32 * w;
    if constexpr (EPI == EPI_F32) {
      float* C = (float*)(ws + OFF_M);
#pragma unroll
      for (int j = 0; j < 4; ++j)
#pragma unroll
        for (int i = 0; i < 16; ++i) C[(size_t)(m0 + 32 * w + crow(i, g)) * 1024 + n0 + 32 * j + r] = acc[j][i];
    } else if constexpr (EPI == EPI_MLA_IN) {
      bf16* hb = (bf16*)(ws + OFF_HB);
      if (nt < 5) {
#pragma unroll
        for (int j = 0; j < 4; ++j)
#pragma unroll
          for (int i = 0; i < 16; ++i) hb[(size_t)(m0 + 32 * w + crow(i, g)) * 640 + n0 + 32 * j + r] = f2bf(acc[j][i]);
        float* rss = (float*)(ws + OFF_RSS);
#pragma unroll
        for (int i = 0; i < 16; ++i) {
          float ss = acc[0][i] * acc[0][i] + acc[1][i] * acc[1][i] + acc[2][i] * acc[2][i] + acc[3][i] * acc[3][i];
          ss += __shfl_xor(ss, 16); ss += __shfl_xor(ss, 8); ss += __shfl_xor(ss, 4); ss += __shfl_xor(ss, 2); ss += __shfl_xor(ss, 1);
          if (r == 0) rss[(size_t)(m0 + 32 * w + crow(i, g)) * 8 + nt] = ss;
        }
      } else {
        const float2* t64 = (const float2*)(ws + OFF_TAB64);
        bf16* Kb = (bf16*)(ws + OFF_K);
#pragma unroll
        for (int i = 0; i < 16; ++i) {
          int s = s0 + crow(i, g);
          float2 cs = t64[s * 32 + r];
          float x1 = acc[0][i], x2 = acc[1][i];
          bf16 o1 = f2bf(x1 * cs.x - x2 * cs.y), o2 = f2bf(x2 * cs.x + x1 * cs.y);
#pragma unroll
          for (int hh = 0; hh < 8; ++hh) {
            bf16* kp = Kb + ((size_t)(bidx * 8 + hh) * 2048 + s) * 192 + 128;
            kp[r] = o1; kp[32 + r] = o2;
          }
        }
      }
    } else if constexpr (EPI == EPI_MLA_Q) {
      bf16* Qb = (bf16*)(ws + OFF_Q);
      const float2* t64 = (const float2*)(ws + OFF_TAB64);
      __syncthreads();
#pragma unroll
      for (int j = 0; j < 4; ++j) {
        const int n = n0 + 32 * j;
        const int hh = n / 192, d0 = n % 192;
        if (d0 < 128) {
#pragma unroll
          for (int i = 0; i < 16; ++i) {
            int rl = 32 * w + crow(i, g);
            int s = (m0 & 2047) + rl;
            Qb[((size_t)(bidx * 8 + hh) * 2048 + s) * 192 + d0 + r] = f2bf(acc[j][i] * rs[rl]);
          }
        } else if (d0 == 128) {
          if (j < 3) {
#pragma unroll
            for (int i = 0; i < 16; ++i) {
              int rl = 32 * w + crow(i, g);
              int s = (m0 & 2047) + rl;
              float2 cs = t64[s * 32 + r];
              float x1 = acc[j][i] * rs[rl], x2 = acc[(j + 1) & 3][i] * rs[rl];
              bf16* qp = Qb + ((size_t)(bidx * 8 + hh) * 2048 + s) * 192 + 128;
              qp[r] = f2bf(x1 * cs.x - x2 * cs.y);
              qp[32 + r] = f2bf(x2 * cs.x + x1 * cs.y);
            }
          }
        }
      }
    } else if constexpr (EPI == EPI_MLA_KV) {
      __syncthreads();
      const int hh = nt >> 1;
      if ((nt & 1) == 0) {
        bf16* Kb = (bf16*)(ws + OFF_K);
#pragma unroll
        for (int j = 0; j < 4; ++j)
#pragma unroll
          for (int i = 0; i < 16; ++i) {
            int rl = 32 * w + crow(i, g);
            int s = (m0 & 2047) + rl;
            Kb[((size_t)(bidx * 8 + hh) * 2048 + s) * 192 + 32 * j + r] = f2bf(acc[j][i] * rs[rl]);
          }
      } else {
        bf16* Vt = (bf16*)(ws + OFF_VT);
#pragma unroll
        for (int j = 0; j < 4; ++j)
#pragma unroll
          for (int qd = 0; qd < 4; ++qd) {
            int rl = 32 * w + 8 * qd + 4 * g;
            int s = (m0 & 2047) + rl;
            uint2 o;
            o.x = pack2(acc[j][4 * qd] * rs[rl], acc[j][4 * qd + 1] * rs[rl + 1]);
            o.y = pack2(acc[j][4 * qd + 2] * rs[rl + 2], acc[j][4 * qd + 3] * rs[rl + 3]);
            *(uint2*)(Vt + (((size_t)(bidx * 8 + hh) * 32 + (s >> 6)) * 128 + 32 * j + r) * 64 + (s & 63)) = o;
          }
      }
    } else if constexpr (EPI == EPI_DSA_IN) {
      const float2* t64 = (const float2*)(ws + OFF_TAB64);
      const float2* t128 = (const float2*)(ws + OFF_TAB128);
      if (nt < 16) {
        bf16* dst = (bf16*)(ws + (nt < 8 ? OFF_Q : OFF_K));
        const int hh = nt & 7;
#pragma unroll
        for (int j = 0; j < 2; ++j)
#pragma unroll
          for (int i = 0; i < 16; ++i) {
            int s = s0 + crow(i, g);
            int d = 32 * j + r;
            float2 cs = t128[s * 64 + d];
            float x1 = acc[j][i], x2 = acc[j + 2][i];
            bf16* qp = dst + ((size_t)(bidx * 8 + hh) * 2048 + s) * 128;
            qp[d] = f2bf(x1 * cs.x - x2 * cs.y);
            qp[d + 64] = f2bf(x2 * cs.x + x1 * cs.y);
          }
      } else if (nt < 24) {
        bf16* Vt = (bf16*)(ws + OFF_VT);
        const int hh = nt - 16;
#pragma unroll
        for (int j = 0; j < 4; ++j)
#pragma unroll
          for (int qd = 0; qd < 4; ++qd) {
            int s = s0 + 8 * qd + 4 * g;
            uint2 o;
            o.x = pack2(acc[j][4 * qd], acc[j][4 * qd + 1]);
            o.y = pack2(acc[j][4 * qd + 2], acc[j][4 * qd + 3]);
            *(uint2*)(Vt + (((size_t)(bidx * 8 + hh) * 32 + (s >> 6)) * 128 + 32 * j + r) * 64 + (s & 63)) = o;
          }
      } else if (nt < 28) {
        bf16* qi = (bf16*)(ws + OFF_QI);
#pragma unroll
        for (int jp = 0; jp < 2; ++jp)
#pragma unroll
          for (int i = 0; i < 16; ++i) {
            int rl = 32 * w + crow(i, g);
            int s = (m0 & 2047) + rl;
            float2 cs = t64[s * 32 + r];
            float x1 = acc[2 * jp][i], x2 = acc[2 * jp + 1][i];
            int ih = 2 * (nt - 24) + jp;
            bf16* qp = qi + ((size_t)(m0 + rl) * 8 + ih) * 64;
            qp[r] = f2bf(x1 * cs.x - x2 * cs.y);
            qp[32 + r] = f2bf(x2 * cs.x + x1 * cs.y);
          }
      } else {
        bf16* ki = (bf16*)(ws + OFF_KI);
        float* wi = (float*)(ws + OFF_WI);
#pragma unroll
        for (int i = 0; i < 16; ++i) {
          int rl = 32 * w + crow(i, g);
          int s = (m0 & 2047) + rl;
          float2 cs = t64[s * 32 + r];
          float x1 = acc[0][i], x2 = acc[1][i];
          bf16* kp = ki + (size_t)(m0 + rl) * 64;
          kp[r] = f2bf(x1 * cs.x - x2 * cs.y);
          kp[32 + r] = f2bf(x2 * cs.x + x1 * cs.y);
          if (r < 8) wi[(size_t)(m0 + rl) * 8 + r] = acc[2][i] * 0.044194173824159216f;
        }
      }
    }
  }
}

template <int DQ, bool MASK>
DI void attn_phase(const Params& p, unsigned char* smem, float cexp) {
  unsigned char* ws = p.ws;
  const bf16* Qb = (const bf16*)(ws + OFF_Q);
  const bf16* Kb = (const bf16*)(ws + OFF_K);
  const bf16* Vt = (const bf16*)(ws + OFF_VT);
  const u64* mask = (const u64*)(ws + OFF_MASK);
  bf16* outp = (bf16*)(ws + OFF_XB);
  constexpr int KST = DQ + 8;
  constexpr int VST = 68;
  bf16* Ks = (bf16*)smem;
  bf16* Vs = Ks + 64 * KST;
  const int tid = opaque_tid(), lane = tid & 63, w = tid >> 6, r = lane & 31, g = lane >> 5;
  for (int it = blockIdx.x; it < 1024; it += gridDim.x) {
    const int seg = it >> 9, idx = it & 511, lv = idx >> 6, bh = idx & 63;
    const int qb = seg == 0 ? 15 - lv : lv;
    const int q0 = qb * 128;
    const int ntile_block = 2 * qb + 2, my_nt = 2 * qb + 1 + (w >> 1);
    const int b = bh >> 3, h = bh & 7;
    const size_t tok = (size_t)b * 2048 + q0 + 32 * w + r;
    bf16x8 qf[DQ / 16];
    {
      const bf16* qp = Qb + ((size_t)bh * 2048 + q0 + 32 * w + r) * DQ + 8 * g;
#pragma unroll
      for (int s = 0; s < DQ / 16; ++s) qf[s] = *(const bf16x8*)(qp + 16 * s);
    }
    f32x16 o[4];
#pragma unroll
    for (int j = 0; j < 4; ++j)
#pragma unroll
      for (int i = 0; i < 16; ++i) o[j][i] = 0.f;
    float m = -INFINITY, l = 0.f;
    for (int kt = 0; kt < ntile_block; ++kt) {
      __syncthreads();
      {
        constexpr int CPR = DQ / 8;
#pragma unroll
        for (int i = 0; i < DQ / 32; ++i) {
          int c = tid + 256 * i;
          int row = c / CPR, cc = c % CPR;
          uint4 v = *(const uint4*)(Kb + ((size_t)bh * 2048 + kt * 64 + row) * DQ + cc * 8);
          *(uint4*)(Ks + row * KST + cc * 8) = v;
        }
#pragma unroll
        for (int i = 0; i < 4; ++i) {
          int c = tid + 256 * i;
          int d = c >> 3, cc = c & 7;
          uint4 v = *(const uint4*)(Vt + (((size_t)bh * 32 + kt) * 128 + d) * 64 + cc * 8);
          uint2* dp = (uint2*)(Vs + d * VST + cc * 8);
          dp[0] = make_uint2(v.x, v.y);
          dp[1] = make_uint2(v.z, v.w);
        }
      }
      __syncthreads();
      if (kt < my_nt) {
        f32x16 sa[2];
#pragma unroll
        for (int u = 0; u < 2; ++u) {
#pragma unroll
          for (int i = 0; i < 16; ++i) sa[u][i] = 0.f;
#pragma unroll
          for (int s = 0; s < DQ / 16; ++s) {
            bf16x8 a = *(const bf16x8*)(Ks + (32 * u + r) * KST + 16 * s + 8 * g);
            sa[u] = MFMA(a, qf[s], sa[u]);
          }
        }
        if (MASK) {
          u64 mw = mask[tok * 32 + kt] >> (4 * g);
          const u32 mlo = (u32)mw, mhi = (u32)(mw >> 32);
#pragma unroll
          for (int i = 0; i < 16; ++i) {
            const u32 bit = 1u << ((i & 3) + 8 * (i >> 2));
            if (!(mlo & bit)) sa[0][i] = -INFINITY;
            if (!(mhi & bit)) sa[1][i] = -INFINITY;
          }
        }
        float mx = -INFINITY;
#pragma unroll
        for (int u = 0; u < 2; ++u)
#pragma unroll
          for (int i = 0; i < 16; ++i) mx = fmaxf(mx, sa[u][i]);
        mx = fmaxf(mx, __shfl_xor(mx, 32));
        float mnew = fmaxf(m, mx);
        float muse = (mnew == -INFINITY) ? 0.f : mnew;
        float alpha = __builtin_amdgcn_exp2f((m - muse) * cexp);
        m = mnew;
        float ps = 0.f;
#pragma unroll
        for (int u = 0; u < 2; ++u)
#pragma unroll
          for (int i = 0; i < 16; ++i) {
            float pv = __builtin_amdgcn_exp2f((sa[u][i] - muse) * cexp);
            ps += pv;
            sa[u][i] = pv;
          }
        l = l * alpha + ps;
#pragma unroll
        for (int j = 0; j < 4; ++j)
#pragma unroll
          for (int i = 0; i < 16; ++i) o[j][i] *= alpha;
#pragma unroll
        for (int u = 0; u < 2; ++u)
#pragma unroll
          for (int s2 = 0; s2 < 2; ++s2) {
            uint4 pp;
            pp.x = pack2(sa[u][8 * s2 + 0], sa[u][8 * s2 + 1]);
            pp.y = pack2(sa[u][8 * s2 + 2], sa[u][8 * s2 + 3]);
            pp.z = pack2(sa[u][8 * s2 + 4], sa[u][8 * s2 + 5]);
            pp.w = pack2(sa[u][8 * s2 + 6], sa[u][8 * s2 + 7]);
            bf16x8 pf = __builtin_bit_cast(bf16x8, pp);
#pragma unroll
            for (int dt = 0; dt < 4; ++dt) {
              const bf16* vp = Vs + (32 * dt + r) * VST + 32 * u + 16 * s2 + 4 * g;
              s16x4 lo = *(const s16x4*)vp;
              s16x4 hi = *(const s16x4*)(vp + 8);
              bf16x8 vf = __builtin_shufflevector(lo, hi, 0, 1, 2, 3, 4, 5, 6, 7);
              o[dt] = MFMA(vf, pf, o[dt]);
            }
          }
      }
    }
    float lt = l + __shfl_xor(l, 32);
    float inv = 1.f / lt;
    bf16* op = outp + tok * 1024 + h * 128;
#pragma unroll
    for (int dt = 0; dt < 4; ++dt)
#pragma unroll
      for (int qd = 0; qd < 4; ++qd) {
        uint2 ov;
        ov.x = pack2(o[dt][4 * qd] * inv, o[dt][4 * qd + 1] * inv);
        ov.y = pack2(o[dt][4 * qd + 2] * inv, o[dt][4 * qd + 3] * inv);
        *(uint2*)(op + 32 * dt + 8 * qd + 4 * g) = ov;
      }
  }
}

DI void indexer_phase(const Params& p, unsigned char* smem) {
  unsigned char* ws = p.ws;
  const bf16* qi = (const bf16*)(ws + OFF_QI);
  const bf16* ki = (const bf16*)(ws + OFF_KI);
  const float* wi = (const float*)(ws + OFF_WI);
  u64* mask = (u64*)(ws + OFF_MASK);
  u32* sc = (u32*)smem;
  const int tid = opaque_tid(), lane = tid & 63, w = tid >> 6, r = lane & 31, g = lane >> 5;
  for (int it = blockIdx.x; it < 2048; it += gridDim.x) {
    const int seg = it >> 9, idx = it & 511, j8 = idx >> 6, sub = idx & 63;
    const int chunk = seg == 0 ? 31 - j8 : seg == 1 ? 16 + j8 : seg == 2 ? 15 - j8 : j8;
    const int b = sub >> 3, sl = sub & 7;
    const int tok0 = b * 2048 + chunk * 64 + sl * 8;
    const int n = (chunk + 1) * 64;
    const int nw = chunk + 1;
    if (chunk < 4) {
      int q = tid >> 5, j = tid & 31;
      mask[(size_t)(tok0 + q) * 32 + j] = (j < nw) ? ~0ull : 0ull;
      continue;
    }
    bf16x8 af[2][4];
    float wv[2][2][8];
    {
      const int head = (r & 3) + 4 * ((r >> 3) & 1);
      const int ql = ((r >> 2) & 1) + 2 * (r >> 4);
#pragma unroll
      for (int rt = 0; rt < 2; ++rt) {
        const bf16* ap = qi + ((size_t)(tok0 + 4 * rt + ql) * 8 + head) * 64 + 8 * g;
#pragma unroll
        for (int s = 0; s < 4; ++s) af[rt][s] = *(const bf16x8*)(ap + 16 * s);
#pragma unroll
        for (int qs = 0; qs < 2; ++qs) {
          const float* wp = wi + (size_t)(tok0 + 4 * rt + g + 2 * qs) * 8;
          float4 w0 = *(const float4*)wp, w1 = *(const float4*)(wp + 4);
          wv[rt][qs][0] = w0.x; wv[rt][qs][1] = w0.y; wv[rt][qs][2] = w0.z; wv[rt][qs][3] = w0.w;
          wv[rt][qs][4] = w1.x; wv[rt][qs][5] = w1.y; wv[rt][qs][6] = w1.z; wv[rt][qs][7] = w1.w;
        }
      }
    }
    const int nkt = 2 * (chunk + 1);
    {
      bf16x8 bn0, bn1, bn2, bn3;
      {
        const bf16* kp = ki + ((size_t)(b * 2048 + 32 * w + r)) * 64 + 8 * g;
        bn0 = *(const bf16x8*)(kp); bn1 = *(const bf16x8*)(kp + 16); bn2 = *(const bf16x8*)(kp + 32); bn3 = *(const bf16x8*)(kp + 48);
      }
      for (int kt = w; kt < nkt; kt += 4) {
        const bf16x8 b0 = bn0, b1 = bn1, b2 = bn2, b3 = bn3;
        if (kt + 4 < nkt) {
          const bf16* kp = ki + ((size_t)(b * 2048 + 32 * (kt + 4) + r)) * 64 + 8 * g;
          bn0 = *(const bf16x8*)(kp); bn1 = *(const bf16x8*)(kp + 16); bn2 = *(const bf16x8*)(kp + 32); bn3 = *(const bf16x8*)(kp + 48);
        }
#pragma unroll
        for (int rt = 0; rt < 2; ++rt) {
          f32x16 a;
#pragma unroll
          for (int i = 0; i < 16; ++i) a[i] = 0.f;
          a = MFMA(af[rt][0], b0, a); a = MFMA(af[rt][1], b1, a); a = MFMA(af[rt][2], b2, a); a = MFMA(af[rt][3], b3, a);
          float s0 = 0.f, s1 = 0.f;
#pragma unroll
          for (int i = 0; i < 8; ++i) {
            s0 += wv[rt][0][i] * fmaxf(a[i], 0.f);
            s1 += wv[rt][1][i] * fmaxf(a[8 + i], 0.f);
          }
          sc[(4 * rt + g) * SCROW + 33 * kt + r] = sortable(s0);
          sc[(4 * rt + g + 2) * SCROW + 33 * kt + r] = sortable(s1);
        }
      }
    }
    __syncthreads();
    for (int qq = 0; qq < 2; ++qq) {
      const int ql = 2 * w + qq;
      const u32* row = sc + ql * SCROW;
      u32 Tt;
      int cge;
      if (nw <= 8) Tt = bisect256<8>(row, lane, nw, cge);
      else if (nw <= 16) Tt = bisect256<16>(row, lane, nw, cge);
      else if (nw <= 24) Tt = bisect256<24>(row, lane, nw, cge);
      else Tt = bisect256<32>(row, lane, nw, cge);
      const bool lane_ok = (lane < 2 * nw);
      if (cge == 256) {
        u32 bits = 0u;
#pragma unroll
        for (int jj = 0; jj < 32; ++jj) {
          const u32 val = lane_ok ? row[33 * lane + jj] : 0u;
          bits |= ((u32)cmp_ge_u(val, Tt) << jj);
        }
        ((u32*)mask)[(size_t)(tok0 + ql) * 64 + lane] = bits;
        continue;
      }
      u32 wv2[32];
      int gtc = 0, eqc = 0;
#pragma unroll
      for (int jj = 0; jj < 32; ++jj) {
        u32 val = lane_ok ? row[33 * lane + jj] : 0u;
        wv2[jj] = val;
        gtc += cmp_gt_u(val, Tt);
        eqc += cmp_eq_u(val, Tt);
      }
      const int cgt = wave_sum_i(gtc);
      const int need = 256 - cgt;
      int incl = eqc;
#pragma unroll
      for (int off = 1; off < 64; off <<= 1) { int t = __shfl_up(incl, off); if (lane >= off) incl += t; }
      int rank = incl - eqc;
      u32 bits = 0u;
#pragma unroll
      for (int jj = 0; jj < 32; ++jj) {
        int eq = cmp_eq_u(wv2[jj], Tt);
        int sel = cmp_gt_u(wv2[jj], Tt) | (eq & (int)(((u32)(rank - need)) >> 31));
        rank += eq;
        bits |= ((u32)sel << jj);
      }
      if (!lane_ok) bits = 0u;
      ((u32*)mask)[(size_t)(tok0 + ql) * 64 + lane] = bits;
    }
    __syncthreads();
  }
}

template <typename XT>
DI void ln1_phase(const Params& p, const XT* __restrict__ xin, const float* __restrict__ mm, const float* __restrict__ gain, const float* __restrict__ bias,
                  float* __restrict__ of, bf16* __restrict__ ob) {
  const int tid = opaque_tid(), lane = tid & 63, w = tid >> 6;
  for (int t = blockIdx.x * 4 + w; t < T_TOK; t += gridDim.x * 4) {
    float v[16];
#pragma unroll
    for (int i = 0; i < 4; ++i) {
      float4 a;
      if constexpr (sizeof(XT) == 4) {
        a = *(const float4*)((const float*)xin + (size_t)t * 1024 + 4 * lane + 256 * i);
      } else {
        const uint2 ab = *(const uint2*)((const bf16*)xin + (size_t)t * 1024 + 4 * lane + 256 * i);
        a = make_float4(bflo(ab.x), bfhi(ab.x), bflo(ab.y), bfhi(ab.y));
      }
      float4 c = *(const float4*)(mm + (size_t)t * 1024 + 4 * lane + 256 * i);
      v[4 * i] = DN_ALPHA * a.x + c.x; v[4 * i + 1] = DN_ALPHA * a.y + c.y; v[4 * i + 2] = DN_ALPHA * a.z + c.z; v[4 * i + 3] = DN_ALPHA * a.w + c.w;
    }
    float s = 0.f;
#pragma unroll
    for (int i = 0; i < 16; ++i) s += v[i];
    float mu = wave_sum(s) * (1.f / 1024.f);
    float q = 0.f;
#pragma unroll
    for (int i = 0; i < 16; ++i) { float d = v[i] - mu; q += d * d; }
    float rstd = rsqrtf(wave_sum(q) * (1.f / 1024.f) + 1e-5f);
#pragma unroll
    for (int i = 0; i < 4; ++i) {
      float4 gg = *(const float4*)(gain + 4 * lane + 256 * i);
      float4 bb = *(const float4*)(bias + 4 * lane + 256 * i);
      float4 o;
      o.x = (v[4 * i] - mu) * rstd * gg.x + bb.x; o.y = (v[4 * i + 1] - mu) * rstd * gg.y + bb.y;
      o.z = (v[4 * i + 2] - mu) * rstd * gg.z + bb.z; o.w = (v[4 * i + 3] - mu) * rstd * gg.w + bb.w;
      if (of) *(float4*)(of + (size_t)t * 1024 + 4 * lane + 256 * i) = o;
      if (ob) *(uint2*)(ob + (size_t)t * 1024 + 4 * lane + 256 * i) = make_uint2(pack2(o.x, o.y), pack2(o.z, o.w));
    }
  }
}

DI u32 xcc_id() { return (u32)__builtin_amdgcn_s_getreg((3 << 11) | 20) & 7u; }
DI float fdot2(u32 a, u32 b, float c) { return __builtin_amdgcn_fdot2_f32_bf16(__builtin_bit_cast(bf2, a), __builtin_bit_cast(bf2, b), c, false); }
DI float dot8(u32x4 a, u32x4 b, float acc) {
  acc = fdot2(a.x, b.x, acc); acc = fdot2(a.y, b.y, acc); acc = fdot2(a.z, b.z, acc); acc = fdot2(a.w, b.w, acc);
  return acc;
}

#define CEX(a, b) { const u32 hi_ = max(a, b), lo_ = min(a, b); a = hi_; b = lo_; }
DI void sort16_desc(u32 (&a)[16]) {
  CEX(a[0], a[1])
  CEX(a[3], a[2])
  CEX(a[4], a[5])
  CEX(a[7], a[6])
  CEX(a[8], a[9])
  CEX(a[11], a[10])
  CEX(a[12], a[13])
  CEX(a[15], a[14])
  CEX(a[0], a[2])
  CEX(a[1], a[3])
  CEX(a[6], a[4])
  CEX(a[7], a[5])
  CEX(a[8], a[10])
  CEX(a[9], a[11])
  CEX(a[14], a[12])
  CEX(a[15], a[13])
  CEX(a[0], a[1])
  CEX(a[2], a[3])
  CEX(a[5], a[4])
  CEX(a[7], a[6])
  CEX(a[8], a[9])
  CEX(a[10], a[11])
  CEX(a[13], a[12])
  CEX(a[15], a[14])
  CEX(a[0], a[4])
  CEX(a[1], a[5])
  CEX(a[2], a[6])
  CEX(a[3], a[7])
  CEX(a[12], a[8])
  CEX(a[13], a[9])
  CEX(a[14], a[10])
  CEX(a[15], a[11])
  CEX(a[0], a[2])
  CEX(a[1], a[3])
  CEX(a[4], a[6])
  CEX(a[5], a[7])
  CEX(a[10], a[8])
  CEX(a[11], a[9])
  CEX(a[14], a[12])
  CEX(a[15], a[13])
  CEX(a[0], a[1])
  CEX(a[2], a[3])
  CEX(a[4], a[5])
  CEX(a[6], a[7])
  CEX(a[9], a[8])
  CEX(a[11], a[10])
  CEX(a[13], a[12])
  CEX(a[15], a[14])
  CEX(a[0], a[8])
  CEX(a[1], a[9])
  CEX(a[2], a[10])
  CEX(a[3], a[11])
  CEX(a[4], a[12])
  CEX(a[5], a[13])
  CEX(a[6], a[14])
  CEX(a[7], a[15])
  CEX(a[0], a[4])
  CEX(a[1], a[5])
  CEX(a[2], a[6])
  CEX(a[3], a[7])
  CEX(a[8], a[12])
  CEX(a[9], a[13])
  CEX(a[10], a[14])
  CEX(a[11], a[15])
  CEX(a[0], a[2])
  CEX(a[1], a[3])
  CEX(a[4], a[6])
  CEX(a[5], a[7])
  CEX(a[8], a[10])
  CEX(a[9], a[11])
  CEX(a[12], a[14])
  CEX(a[13], a[15])
  CEX(a[0], a[1])
  CEX(a[2], a[3])
  CEX(a[4], a[5])
  CEX(a[6], a[7])
  CEX(a[8], a[9])
  CEX(a[10], a[11])
  CEX(a[12], a[13])
  CEX(a[14], a[15])
}
DI void merge16_desc(u32 (&a)[16], const u32 (&b)[16]) {
#pragma unroll
  for (int k = 0; k < 16; ++k) a[k] = max(a[k], b[15 - k]);
  CEX(a[0], a[8])
  CEX(a[1], a[9])
  CEX(a[2], a[10])
  CEX(a[3], a[11])
  CEX(a[4], a[12])
  CEX(a[5], a[13])
  CEX(a[6], a[14])
  CEX(a[7], a[15])
  CEX(a[0], a[4])
  CEX(a[1], a[5])
  CEX(a[2], a[6])
  CEX(a[3], a[7])
  CEX(a[8], a[12])
  CEX(a[9], a[13])
  CEX(a[10], a[14])
  CEX(a[11], a[15])
  CEX(a[0], a[2])
  CEX(a[1], a[3])
  CEX(a[4], a[6])
  CEX(a[5], a[7])
  CEX(a[8], a[10])
  CEX(a[9], a[11])
  CEX(a[12], a[14])
  CEX(a[13], a[15])
  CEX(a[0], a[1])
  CEX(a[2], a[3])
  CEX(a[4], a[5])
  CEX(a[6], a[7])
  CEX(a[8], a[9])
  CEX(a[10], a[11])
  CEX(a[12], a[13])
  CEX(a[14], a[15])
}

DI void peer1_phase(const Params& p, unsigned char* smem, const bf16* __restrict__ A, const bf16* __restrict__ Bt, int layer) {
  unsigned char* ws = p.ws;
  bf16* As = (bf16*)smem;
  bf16* Bs = As + 128 * LDT;
  bf16* Qs = (bf16*)smem;
  u32* pkl = (u32*)(smem + 40960);
  int* exo = (int*)(ws + OFF_EX);
  float* gto = (float*)(ws + OFF_GT);
  const int tid = opaque_tid(), lane = tid & 63, w = tid >> 6, r = lane & 31, g = lane >> 5;
  for (int item = blockIdx.x; item < 1024; item += gridDim.x) {
    const int mt = item >> 3, hh = item & 7;
    const int m0 = mt * 128;
    for (int half = 0; half < 2; ++half) {
      const int n0 = (2 * hh + half) * 128;
      f32x16 acc[4];
      gemm_mainloop(A, 1024, Bt, 1024, 1024, m0, n0, As, Bs, acc[0], acc[1], acc[2], acc[3]);
      __syncthreads();
#pragma unroll
      for (int j = 0; j < 4; ++j)
#pragma unroll
        for (int i = 0; i < 16; ++i) Qs[(32 * w + crow(i, g)) * 136 + 32 * j + r] = f2bf(acc[j][i]);
      __syncthreads();
      int sklo = r * 128 + 8 * g;
      asm volatile("" : "+v"(sklo));
      const bf16* sk = (const bf16*)(ws + OFF_SUBK) + (((size_t)layer * 2 + half) * 8 + hh) * 128 * 128 + sklo;
      f32x16 sc[4];
#pragma unroll
      for (int j = 0; j < 4; ++j)
#pragma unroll
        for (int i = 0; i < 16; ++i) sc[j][i] = 0.f;
      {
        bf16x8 skf[8][4];
#pragma unroll
        for (int s = 0; s < 8; ++s)
#pragma unroll
          for (int n4 = 0; n4 < 4; ++n4) skf[s][n4] = *(const bf16x8*)(sk + (32 * n4) * 128 + 16 * s);
        __builtin_amdgcn_sched_barrier(0);
#pragma unroll
        for (int s = 0; s < 8; ++s) {
          bf16x8 bq = *(const bf16x8*)(Qs + (32 * w + r) * 136 + 16 * s + 8 * g);
#pragma unroll
          for (int n4 = 0; n4 < 4; ++n4) sc[n4] = MFMA(skf[s][n4], bq, sc[n4]);
        }
      }
      u32 L[16];
      {
        u32 G1[16], G2[16], G3[16];
#pragma unroll
        for (int i = 0; i < 16; ++i) {
          const int nc = (i & 3) + 8 * (i >> 2);
          L[i]  = (sortable(sc[0][i]) & ~127u) | (u32)(127 - nc);
          G1[i] = (sortable(sc[1][i]) & ~127u) | (u32)(127 - 32 - nc);
          G2[i] = (sortable(sc[2][i]) & ~127u) | (u32)(127 - 64 - nc);
          G3[i] = (sortable(sc[3][i]) & ~127u) | (u32)(127 - 96 - nc);
        }
        sort16_desc(L); sort16_desc(G1); sort16_desc(G2); sort16_desc(G3);
        merge16_desc(L, G1); merge16_desc(G2, G3); merge16_desc(L, G2);
      }
#pragma unroll
      for (int k = 0; k < 16; ++k) L[k] ^= (u32)(g << 2);
      u32 R[16];
#pragma unroll
      for (int k = 0; k < 16; ++k) R[k] = (u32)__shfl_xor((int)L[k], 32);
      merge16_desc(L, R);
      if (g == 0) {
        u32* pk = pkl + (half * 128 + 32 * w + r) * 16;
#pragma unroll
        for (int k4 = 0; k4 < 4; ++k4) *(uint4*)(pk + 4 * k4) = make_uint4(L[4 * k4], L[4 * k4 + 1], L[4 * k4 + 2], L[4 * k4 + 3]);
      }
    }
    __syncthreads();
    if (tid < 128) {
      const u32* p1 = pkl + tid * 16;
      const u32* p2 = pkl + (128 + tid) * 16;
      float v1[16], v2[16];
#pragma unroll
      for (int k4 = 0; k4 < 4; ++k4) {
        uint4 a = *(const uint4*)(p1 + 4 * k4), c = *(const uint4*)(p2 + 4 * k4);
        v1[4 * k4] = unsortable(a.x & ~127u); v1[4 * k4 + 1] = unsortable(a.y & ~127u); v1[4 * k4 + 2] = unsortable(a.z & ~127u); v1[4 * k4 + 3] = unsortable(a.w & ~127u);
        v2[4 * k4] = unsortable(c.x & ~127u); v2[4 * k4 + 1] = unsortable(c.y & ~127u); v2[4 * k4 + 2] = unsortable(c.z & ~127u); v2[4 * k4 + 3] = unsortable(c.w & ~127u);
      }
      u32 L[16];
#pragma unroll
      for (int k = 0; k < 16; ++k) L[k] = 0u;
#pragma unroll
      for (int i = 0; i < 16; ++i)
#pragma unroll
        for (int j = 0; j < 16; ++j)
          if ((i + 1) * (j + 1) <= 16) {
            u32 key = (sortable(v1[i] + v2[j]) & ~255u) | (u32)(255 - (i * 16 + j));
            ins16(L, key);
          }
      float bv[16];
      float mx = unsortable(L[0] & ~255u);
      float sum = 0.f;
#pragma unroll
      for (int k = 0; k < 16; ++k) { bv[k] = __expf(unsortable(L[k] & ~255u) - mx); sum += bv[k]; }
      float isum = 1.f / sum;
      int ev[16];
#pragma unroll
      for (int k = 0; k < 16; ++k) {
        int pos = 255 - (int)(L[k] & 255u);
        int i1 = 127 - (int)(p1[pos >> 4] & 127u);
        int i2 = 127 - (int)(p2[pos & 15] & 127u);
        ev[k] = i1 * 128 + i2;
        bv[k] *= isum;
      }
      int* eo = exo + (size_t)(m0 + tid) * 128 + hh * 16;
      float* go = gto + (size_t)(m0 + tid) * 128 + hh * 16;
      float* so = (float*)(ws + OFF_SD) + (size_t)(m0 + tid) * 128 + hh * 16;
      const float* rsd = (const float*)(ws + OFF_RSD) + layer * 16384;
      const float* rsu = (const float*)(ws + OFF_RSU) + layer * 16384;
      float sdv[16];
#pragma unroll
      for (int k = 0; k < 16; ++k) { bv[k] *= rsu[ev[k]]; sdv[k] = rsd[ev[k]]; }
#pragma unroll
      for (int k4 = 0; k4 < 4; ++k4) {
        *(int4*)(eo + 4 * k4) = make_int4(ev[4 * k4], ev[4 * k4 + 1], ev[4 * k4 + 2], ev[4 * k4 + 3]);
        *(float4*)(go + 4 * k4) = make_float4(bv[4 * k4], bv[4 * k4 + 1], bv[4 * k4 + 2], bv[4 * k4 + 3]);
        *(float4*)(so + 4 * k4) = make_float4(sdv[4 * k4], sdv[4 * k4 + 1], sdv[4 * k4 + 2], sdv[4 * k4 + 3]);
      }
    }
  }
}

typedef __attribute__((ext_vector_type(4))) float f32x4;
typedef __attribute__((ext_vector_type(2))) long lx2;
constexpr int DN_TOK = 16;
DI void down_issue(u32x4 (&W)[16], const u32* list, int b0, int n, const unsigned char* wd, int lane) {
  const int idx = min(b0 + (lane & 15), n - 1);
  const u32 ent = list[idx];
  const unsigned char* rp = wd + (size_t)(ent & 16383u) * 1024 + 16 * (lane >> 4);
#pragma unroll
  for (int s = 0; s < 16; ++s) W[s] = *(const u32x4*)(rp + 64 * s);
}
DI void down_proc(const u32x4 (&W)[16], const u32x4 (&Bf)[16], const u32* list, const float* xsc, float* dl, int b0, int n, int t0, int lane, u32* __restrict__ hgp) {
  f32x4 acc[4];
#pragma unroll
  for (int i = 0; i < 4; ++i) acc[i] = f32x4{0.f, 0.f, 0.f, 0.f};
#pragma unroll
  for (int s = 0; s < 16; ++s) {
    const lx2 av = __builtin_bit_cast(lx2, W[s]);
    const lx2 bv = __builtin_bit_cast(lx2, Bf[s]);
    acc[(2 * s) & 3] = __builtin_amdgcn_mfma_f32_16x16x32_fp8_fp8(av[0], bv[0], acc[(2 * s) & 3], 0, 0, 0);
    acc[(2 * s + 1) & 3] = __builtin_amdgcn_mfma_f32_16x16x32_fp8_fp8(av[1], bv[1], acc[(2 * s + 1) & 3], 0, 0, 0);
  }
  const f32x4 D = acc[0] + acc[1] + acc[2] + acc[3];
  const int c = lane & 15, g = lane >> 4;
#pragma unroll
  for (int i = 0; i < 4; ++i) dl[(4 * g + i) * 17 + c] = D[i];
  if (lane < 16) {
    const int idx = b0 + lane;
    const int ii = min(idx, n - 1);
    const u32 ent = list[ii];
    const float gl = __uint_as_float(list[2048 + ii]);
    const float sdl = __uint_as_float(list[4096 + ii]);
    const int tl = ent >> 21, k = (ent >> 14) & 127, e = ent & 16383;
    const float a = dl[lane * 17 + tl] * xsc[tl] * sdl;
    const float hgv = 0.5f * a * (1.f + erff(a * 0.70710678118654752f)) * gl;
    if (idx < n) hgp[(size_t)(t0 + tl) * 128 + k] = ((u32)e << 16) | (u32)f2bf(hgv);
  }
}
DI void peer_down_phase(const Params& p, unsigned char* smem, int layer, const bf16* __restrict__ x1b, u32* ctr) {
  unsigned char* ws = p.ws;
  const int* ex = (const int*)(ws + OFF_EX);
  const float* gt = (const float*)(ws + OFF_GT);
  const float* sd = (const float*)(ws + OFF_SD);
  u32* hgp = (u32*)(ws + OFF_HGP);
  const int tid = opaque_tid(), lane = tid & 63, w = tid >> 6;
  const unsigned char* wd = ws + OFF_WDOWN + (size_t)layer * 16384 * 1024;
  int* slot = (int*)smem;
  int* cnt = slot + 4;
  float* xsc = (float*)(smem + 64);
  unsigned char* xs8 = smem + 256;
  u32* list = (u32*)(smem + 256 + 16384);
  float* dl = (float*)(smem + 256 + 16384 + 24576) + w * 16 * 17;
  const u64 ltm = (lane == 0) ? 0ull : (~0ull >> (64 - lane));
  const int xcc16 = (int)xb_xcc_id();
  constexpr int NITEM = T_TOK / DN_TOK;
  __syncthreads();
  if (tid == 0) {
    unsigned* bar = (unsigned*)(ws + OFF_BAR);
    int nx = 0, xi = 0, nloc = 1;
    for (int j = 0; j < 16; ++j) { const unsigned cj = xb_ld(&bar[XB_XCNT(j)]); if (cj > 0u) { if (j == xcc16) { xi = nx; nloc = (int)cj; } ++nx; } }
    slot[0] = (int)atomicAdd(ctr + xcc16, 1u);
    slot[1] = nloc; slot[2] = xi; slot[3] = nx;
    *cnt = 0;
  }
  __syncthreads();
  const int rank = slot[0], nloc = slot[1], xi = slot[2], nx = slot[3];
  for (int slice = xi; slice < 8; slice += nx) {
    for (int item = rank; item < NITEM; item += nloc) {
      __syncthreads();
      const int t0 = item * DN_TOK;
      {
        const int row = tid >> 4, sgm = tid & 15;
        const bf16* xp = x1b + (size_t)(t0 + row) * 1024 + 64 * sgm;
        u32x4 v[8];
#pragma unroll
        for (int i = 0; i < 8; ++i) v[i] = *(const u32x4*)(xp + 8 * i);
        float am = 0.f;
#pragma unroll
        for (int i = 0; i < 8; ++i)
#pragma unroll
          for (int q = 0; q < 4; ++q) am = fmaxf(am, fmaxf(fabsf(bflo(v[i][q])), fabsf(bfhi(v[i][q]))));
        am = fmaxf(am, __shfl_xor(am, 8)); am = fmaxf(am, __shfl_xor(am, 4));
        am = fmaxf(am, __shfl_xor(am, 2)); am = fmaxf(am, __shfl_xor(am, 1));
        const float sc = am > 0.f ? 440.f / am : 1.f;
        if (sgm == 0) xsc[row] = am > 0.f ? am / 440.f : 1.f;
        u32x4* dp = (u32x4*)(xs8 + row * 1024 + 64 * sgm);
#pragma unroll
        for (int i2 = 0; i2 < 4; ++i2) {
          u32 pk[4];
#pragma unroll
          for (int h = 0; h < 2; ++h) {
            const u32x4 vv = v[2 * i2 + h];
            int t1 = __builtin_amdgcn_cvt_pk_fp8_f32(bflo(vv[0]) * sc, bfhi(vv[0]) * sc, 0, false);
            pk[2 * h] = (u32)__builtin_amdgcn_cvt_pk_fp8_f32(bflo(vv[1]) * sc, bfhi(vv[1]) * sc, t1, true);
            int t2 = __builtin_amdgcn_cvt_pk_fp8_f32(bflo(vv[2]) * sc, bfhi(vv[2]) * sc, 0, false);
            pk[2 * h + 1] = (u32)__builtin_amdgcn_cvt_pk_fp8_f32(bflo(vv[3]) * sc, bfhi(vv[3]) * sc, t2, true);
          }
          dp[i2] = u32x4{pk[0], pk[1], pk[2], pk[3]};
        }
      }
#pragma unroll
      for (int i = 0; i < 4; ++i) {
        const int tl = 4 * w + i;
        const size_t ro = (size_t)(t0 + tl) * 128 + lane;
        const int e_lo = ex[ro], e_hi = ex[ro + 64];
        const float g_lo = gt[ro], g_hi = gt[ro + 64], s_lo = sd[ro], s_hi = sd[ro + 64];
        const bool in_lo = (e_lo >> 11) == slice, in_hi = (e_hi >> 11) == slice;
        const u64 mlo = __ballot(in_lo), mhi = __ballot(in_hi);
        const int clo = __popcll(mlo), c = clo + __popcll(mhi);
        int base = 0;
        if (lane == 0) base = atomicAdd(cnt, c);
        base = __builtin_amdgcn_readfirstlane(base);
        if (in_lo) { int pos = base + __popcll(mlo & ltm); list[pos] = ((u32)tl << 21) | ((u32)lane << 14) | (u32)e_lo; list[2048 + pos] = __float_as_uint(g_lo); list[4096 + pos] = __float_as_uint(s_lo); }
        if (in_hi) { int pos = base + clo + __popcll(mhi & ltm); list[pos] = ((u32)tl << 21) | ((u32)(64 + lane) << 14) | (u32)e_hi; list[2048 + pos] = __float_as_uint(g_hi); list[4096 + pos] = __float_as_uint(s_hi); }
      }
      __syncthreads();
      const int n = *cnt;
      if (n > 0) {
        const int nb = (n + 15) >> 4;
        u32x4 Bf[16];
        {
          const unsigned char* bp = xs8 + (lane & 15) * 1024 + 16 * (lane >> 4);
#pragma unroll
          for (int s2 = 0; s2 < 16; ++s2) Bf[s2] = *(const u32x4*)(bp + 64 * s2);
        }
        u32x4 WA[16], WB[16];
        if (w < nb) down_issue(WA, list, 16 * w, n, wd, lane);
        for (int b = w; b < nb; b += 8) {
          down_issue(WB, list, 16 * (b + 4), n, wd, lane);
          __builtin_amdgcn_sched_barrier(0);
          down_proc(WA, Bf, list, xsc, dl, 16 * b, n, t0, lane, hgp);
          __builtin_amdgcn_sched_barrier(0);
          down_issue(WA, list, 16 * (b + 8), n, wd, lane);
          __builtin_amdgcn_sched_barrier(0);
          if (b + 4 < nb) down_proc(WB, Bf, list, xsc, dl, 16 * (b + 4), n, t0, lane, hgp);
          __builtin_amdgcn_sched_barrier(0);
        }
      }
      __syncthreads();
      if (tid == 0) *cnt = 0;
    }
  }
}

DI void xcc_census(unsigned char* ws, u32* rankctr, int* sl, int tid) {
  __syncthreads();
  if (tid == 0) {
    unsigned* bar = (unsigned*)(ws + OFF_BAR);
    const unsigned myx = xb_xcc_id();
    int nx = 0, xo = 0, nloc = 1;
    for (unsigned j = 0; j < 16; ++j) { const unsigned cj = xb_ld(&bar[XB_XCNT(j)]); if (cj > 0u) { if (j == myx) { xo = nx; nloc = (int)cj; } ++nx; } }
    sl[0] = (int)atomicAdd(rankctr + myx, 1u);
    sl[1] = nloc; sl[2] = xo; sl[3] = nx;
  }
  __syncthreads();
}

DI void dn2_issue(u32x4 (&W)[16], const int* pl, const unsigned char* wbase, int grp) {
#pragma unroll
  for (int j = 0; j < 16; ++j) W[j] = *(const u32x4*)(wbase + (size_t)pl[8 * j + grp] * 1024);
}
DI void dn2_math(const u32x4 (&W)[16], u32x4 x0, u32x4 x1, float* __restrict__ parow, int lane) {
  f2 xf[8];
#pragma unroll
  for (int q = 0; q < 4; ++q) { xf[q] = f2{bflo(x0[q]), bfhi(x0[q])}; xf[4 + q] = f2{bflo(x1[q]), bfhi(x1[q])}; }
  float pv[16];
#pragma unroll
  for (int j = 0; j < 16; ++j) {
    f2 s2 = {0.f, 0.f};
#pragma unroll
    for (int d = 0; d < 4; ++d) {
      f2 lo = __builtin_amdgcn_cvt_pk_f32_fp8((int)W[j][d], false);
      f2 hi = __builtin_amdgcn_cvt_pk_f32_fp8((int)W[j][d], true);
      s2 = lo * xf[2 * d] + s2;
      s2 = hi * xf[2 * d + 1] + s2;
    }
    pv[j] = s2.x + s2.y;
  }
  const bool b2 = lane & 4, b1 = lane & 2, b0 = lane & 1;
  float q8[8];
#pragma unroll
  for (int i = 0; i < 8; ++i) { float snd = b2 ? pv[i] : pv[i + 8]; float kp = b2 ? pv[i + 8] : pv[i]; q8[i] = kp + __shfl_xor(snd, 4); }
  float q4[4];
#pragma unroll
  for (int i = 0; i < 4; ++i) { float snd = b1 ? q8[i] : q8[i + 4]; float kp = b1 ? q8[i + 4] : q8[i]; q4[i] = kp + __shfl_xor(snd, 2); }
  float r2[2];
#pragma unroll
  for (int i = 0; i < 2; ++i) { float snd = b0 ? q4[i] : q4[i + 2]; float kp = b0 ? q4[i + 2] : q4[i]; r2[i] = kp + __shfl_xor(snd, 1); }
  const int j0 = (b0 ? 2 : 0) + (b1 ? 4 : 0) + (b2 ? 8 : 0);
  const int grp = lane >> 3;
  parow[8 * j0 + grp] = r2[0];
  parow[8 * (j0 + 1) + grp] = r2[1];
}
DI void peer_down2_phase(const Params& p, unsigned char* smem, int layer, const bf16* __restrict__ x1b, u32* ctr) {
  unsigned char* ws = p.ws;
  const int* ex = (const int*)(ws + OFF_EX);
  const unsigned char* wd = ws + OFF_WDOWN + (size_t)layer * 16384 * 1024;
  float* pa = (float*)(ws + OFF_YB);
  int* slot = (int*)smem;
  const int tid = opaque_tid(), lane = tid & 63, w = tid >> 6;
  const int grp = lane >> 3, c = lane & 7;
  int* pl = (int*)(smem + 256) + w * 2048;
  const int xcc = (int)xcc_id();
  xcc_census(ws, ctr + 8, slot + 4, tid);
  const bool stat = (slot[7] == 8);
  int it_next = slot[4];
  const int it_step = slot[5], xi = slot[6];
  for (int si = 0; si < (stat ? 1 : 8); ++si) {
    const int slice = stat ? xi : ((xcc + si) & 7);
    for (;;) {
      int item;
      if (stat) { item = it_next; it_next += it_step; }
      else {
        __syncthreads();
        if (tid == 0) *slot = (int)atomicAdd(ctr + slice, 1u);
        __syncthreads();
        item = *slot;
      }
      if (item >= 256) break;
      const int t0 = item * 64 + 16 * w;
      const unsigned char* wbase = wd + slice * 128 + c * 16;
      {
        const int* src = ex + (size_t)t0 * 128;
#pragma unroll
        for (int i = 0; i < 32; ++i) pl[i * 64 + lane] = src[i * 64 + lane];
      }
      const bf16* xb0 = x1b + (size_t)t0 * 1024 + slice * 128 + c * 16;
      float* pbase = pa + ((size_t)slice * T_TOK + t0) * 128;
      u32x4 WA[16], WB[16];
      u32x4 xa0, xa1, xb_0, xb_1;
      dn2_issue(WA, pl, wbase, grp);
      xa0 = *(const u32x4*)(xb0); xa1 = *(const u32x4*)(xb0 + 8);
      for (int tl = 0; tl < 16; tl += 2) {
        dn2_issue(WB, pl + (tl + 1) * 128, wbase, grp);
        xb_0 = *(const u32x4*)(xb0 + (size_t)(tl + 1) * 1024); xb_1 = *(const u32x4*)(xb0 + (size_t)(tl + 1) * 1024 + 8);
        __builtin_amdgcn_sched_barrier(0);
        dn2_math(WA, xa0, xa1, pbase + (size_t)tl * 128, lane);
        __builtin_amdgcn_sched_barrier(0);
        if (tl + 2 < 16) {
          dn2_issue(WA, pl + (tl + 2) * 128, wbase, grp);
          xa0 = *(const u32x4*)(xb0 + (size_t)(tl + 2) * 1024); xa1 = *(const u32x4*)(xb0 + (size_t)(tl + 2) * 1024 + 8);
        }
        __builtin_amdgcn_sched_barrier(0);
        dn2_math(WB, xb_0, xb_1, pbase + (size_t)(tl + 1) * 128, lane);
        __builtin_amdgcn_sched_barrier(0);
      }
    }
  }
}
DI void peer_hg_phase(const Params& p) {
  unsigned char* ws = p.ws;
  const int* ex = (const int*)(ws + OFF_EX);
  const float* gt = (const float*)(ws + OFF_GT);
  const float* sd = (const float*)(ws + OFF_SD);
  const float* pa = (const float*)(ws + OFF_YB);
  u32* hgp = (u32*)(ws + OFF_HGP);
  const int tid = opaque_tid();
#pragma unroll 4
  for (size_t i = (size_t)blockIdx.x * 256 + tid; i < (size_t)T_TOK * 128; i += (size_t)gridDim.x * 256) {
    float a = 0.f;
#pragma unroll
    for (int s2 = 0; s2 < 8; ++s2) a += pa[(size_t)s2 * T_TOK * 128 + i];
    a *= sd[i];
    const float hgv = 0.5f * a * (1.f + erff(a * 0.70710678118654752f)) * gt[i];
    hgp[i] = ((u32)ex[i] << 16) | (u32)f2bf(hgv);
  }
}

DI void up_issue(u32x4 (&W)[16], u32 (&pj)[16], const u32* pl, const unsigned char* wbase, int grp) {
#pragma unroll
  for (int j = 0; j < 16; ++j) {
    pj[j] = pl[8 * j + grp];
    W[j] = *(const u32x4*)(wbase + (size_t)(pj[j] >> 16) * 1024);
  }
}
DI void up_math(const u32x4 (&W)[16], const u32 (&pj)[16], float* __restrict__ yrow, int lane) {
  f2 y[8];
#pragma unroll
  for (int i = 0; i < 8; ++i) y[i] = f2{0.f, 0.f};
#pragma unroll
  for (int j = 0; j < 16; ++j) {
    const float h = __uint_as_float(pj[j] << 16);
    const f2 hh = {h, h};
#pragma unroll
    for (int d = 0; d < 4; ++d) {
      f2 lo = __builtin_amdgcn_cvt_pk_f32_fp8((int)W[j][d], false);
      f2 hi = __builtin_amdgcn_cvt_pk_f32_fp8((int)W[j][d], true);
      y[2 * d] = lo * hh + y[2 * d];
      y[2 * d + 1] = hi * hh + y[2 * d + 1];
    }
  }
  const bool b5 = lane & 32, b4 = lane & 16, b3 = lane & 8;
  f2 q4[4];
#pragma unroll
  for (int i = 0; i < 4; ++i) {
    f2 snd = b5 ? y[i] : y[i + 4]; f2 kp = b5 ? y[i + 4] : y[i];
    q4[i] = f2{kp.x + __shfl_xor(snd.x, 32), kp.y + __shfl_xor(snd.y, 32)};
  }
  f2 r2[2];
#pragma unroll
  for (int i = 0; i < 2; ++i) {
    f2 snd = b4 ? q4[i] : q4[i + 2]; f2 kp = b4 ? q4[i + 2] : q4[i];
    r2[i] = f2{kp.x + __shfl_xor(snd.x, 16), kp.y + __shfl_xor(snd.y, 16)};
  }
  f2 a;
  { f2 snd = b3 ? r2[0] : r2[1]; f2 kp = b3 ? r2[1] : r2[0]; a = f2{kp.x + __shfl_xor(snd.x, 8), kp.y + __shfl_xor(snd.y, 8)}; }
  const int ci = (b5 ? 4 : 0) + (b4 ? 2 : 0) + (b3 ? 1 : 0);
  *(float2*)(yrow + (lane & 7) * 16 + 2 * ci) = make_float2(a.x, a.y);
}
DI void peer_up_phase(const Params& p, unsigned char* smem, int layer, u32* ctr) {
  unsigned char* ws = p.ws;
  const u32* hgp = (const u32*)(ws + OFF_HGP);
  const unsigned char* wu = ws + OFF_WUP + (size_t)layer * 16384 * 1024;
  float* yb = (float*)(ws + OFF_YB);
  int* slot = (int*)smem;
  const int tid = opaque_tid(), lane = tid & 63, w = tid >> 6;
  const int grp = lane >> 3, c = lane & 7;
  u32* pl = (u32*)(smem + 256) + w * 2048;
  const int xcc = (int)xcc_id();
  xcc_census(ws, ctr + 8, slot + 4, tid);
  const bool stat = (slot[7] == 8);
  int it_next = slot[4];
  const int it_step = slot[5], xi = slot[6];
  for (int si = 0; si < (stat ? 1 : 8); ++si) {
    const int slice = stat ? xi : ((xcc + si) & 7);
    for (;;) {
      int item;
      if (stat) { item = it_next; it_next += it_step; }
      else {
        __syncthreads();
        if (tid == 0) *slot = (int)atomicAdd(ctr + slice, 1u);
        __syncthreads();
        item = *slot;
      }
      if (item >= 256) break;
      const int t0 = item * 64 + 16 * w;
      const unsigned char* wbase = wu + slice * 128 + c * 16;
      {
        const u32* src = hgp + (size_t)t0 * 128;
#pragma unroll
        for (int i = 0; i < 32; ++i) pl[i * 64 + lane] = src[i * 64 + lane];
      }
      float* ybase = yb + (size_t)t0 * 1024 + slice * 128;
      u32x4 WA[16], WB[16];
      u32 pA[16], pB[16];
      up_issue(WA, pA, pl, wbase, grp);
      for (int tl = 0; tl < 16; tl += 2) {
        up_issue(WB, pB, pl + (tl + 1) * 128, wbase, grp);
        __builtin_amdgcn_sched_barrier(0);
        up_math(WA, pA, ybase + (size_t)tl * 1024, lane);
        __builtin_amdgcn_sched_barrier(0);
        if (tl + 2 < 16) up_issue(WA, pA, pl + (tl + 2) * 128, wbase, grp);
        __builtin_amdgcn_sched_barrier(0);
        up_math(WB, pB, ybase + (size_t)(tl + 1) * 1024, lane);
        __builtin_amdgcn_sched_barrier(0);
      }
    }
  }
}

__global__ void __launch_bounds__(256, 2) fwd_megakernel(Params p) {
  cg::grid_group grid = cg::this_grid();
  __shared__ __attribute__((aligned(16))) unsigned char smem[SMEM_BYTES];
  unsigned char* ws = p.ws;
  __shared__ __attribute__((aligned(16))) unsigned xb_words[4];
  if (threadIdx.x < 4) xb_words[threadIdx.x] = 0u;
  __syncthreads();
  XcdBarrier gbar = xcd_barrier_post((unsigned*)(ws + OFF_BAR), (volatile LAS unsigned*)&xb_words);
  bf16* xb = (bf16*)(ws + OFF_XB);
  bf16* x1b = (bf16*)(ws + OFF_VT);
  float* x1f = p.out;
  bf16* x2b = (bf16*)(ws + OFF_X2F);
  float* mbuf = (float*)(ws + OFF_M);
  bf16* hb = (bf16*)(ws + OFF_HB);
  float* ybuf = (float*)(ws + OFF_YB);
  u32* ctrs = (u32*)(ws + OFF_CTR);

  RUN(0, prep_phase(p, smem))
  if (p.ws == nullptr) grid.sync();
  xcd_barrier(gbar);
  RUN(1, gemm_phase<EPI_MLA_IN>(p, smem, xb, 1024, (const bf16*)(ws + OFF_WIN_T), 1024, 6, 0))
  xcd_barrier(gbar);
  RUN(2, gemm_phase<EPI_MLA_Q>(p, smem, hb, 640, (const bf16*)(ws + OFF_WUQ_T), 384, 12, 0))
  RUN(3, gemm_phase<EPI_MLA_KV>(p, smem, hb + 384, 640, (const bf16*)(ws + OFF_WUKV_T), 256, 16, 0))
  xcd_barrier(gbar);
  for (int pass = 0; pass < 2; ++pass) {
    const bool conv_first = blockIdx.x >= (gridDim.x >> 1);
    if ((pass == 0) == conv_first) {
      fp8_rows(p.peer_w_down, ws + OFF_WDOWN, (float*)(ws + OFF_RSD), 32768);
      fp8_rows(p.peer_w_up, ws + OFF_WUP, (float*)(ws + OFF_RSU), 32768);
    } else {
      RUN(4, attn_phase<192, false>(p, smem, 0.07216878364870322f * 1.4426950408889634f))
    }
  }
  xcd_barrier(gbar);
  RUN(5, gemm_phase<EPI_F32>(p, smem, xb, 1024, (const bf16*)(ws + OFF_WO_T), 1024, 8, 0))
#ifdef HOTEXP
  xcd_barrier(gbar);
  gemm_phase<EPI_F32, HOTEXP>(p, smem, xb, 1024, (const bf16*)(ws + OFF_WO_T), 1024, 8, 0);
#endif
  xcd_barrier(gbar);
  RUN(6, ln1_phase<float>(p, p.x, mbuf, p.ln_gain, p.ln_bias, nullptr, x1b))
  xcd_barrier(gbar);
  RUN(7, peer1_phase(p, smem, x1b, (const bf16*)(ws + OFF_WQ_T), 0))
  xcd_barrier(gbar);
  RUN(8, peer_down2_phase(p, smem, 0, x1b, ctrs))
  xcd_barrier(gbar);
  peer_hg_phase(p);
#ifdef REP_DOWN
  xcd_barrier(gbar);
  peer_down2_phase(p, smem, 0, x1b, ctrs + 160);
#endif
  xcd_barrier(gbar);
  RUN(16, peer_up_phase(p, smem, 0, ctrs + 32))
#ifdef REP_UP
  xcd_barrier(gbar);
  peer_up_phase(p, smem, 0, ctrs + 192);
#endif
  xcd_barrier(gbar);
  RUN(17, ln1_phase<bf16>(p, x1b, ybuf, p.ln_gain + 1024, p.ln_bias + 1024, nullptr, x2b))
  xcd_barrier(gbar);
  RUN(9, gemm_phase<EPI_DSA_IN>(p, smem, x2b, 1024, (const bf16*)(ws + OFF_DIN_T), 1024, 29, 1))
  xcd_barrier(gbar);
  RUN(10, indexer_phase(p, smem))
  xcd_barrier(gbar);
  RUN(11, attn_phase<128, true>(p, smem, 0.08838834764831845f * 1.4426950408889634f))
  xcd_barrier(gbar);
  RUN(12, gemm_phase<EPI_F32>(p, smem, xb, 1024, (const bf16*)(ws + OFF_DO_T), 1024, 8, 1))
  xcd_barrier(gbar);
  RUN(13, ln1_phase<bf16>(p, x2b, mbuf, p.ln_gain + 2048, p.ln_bias + 2048, nullptr, x1b))
  xcd_barrier(gbar);
  RUN(14, peer1_phase(p, smem, x1b, (const bf16*)(ws + OFF_WQ_T) + (size_t)2048 * 1024, 1))
  xcd_barrier(gbar);
  RUN(15, peer_down2_phase(p, smem, 1, x1b, ctrs + 64))
  xcd_barrier(gbar);
  peer_hg_phase(p);
  xcd_barrier(gbar);
  RUN(18, peer_up_phase(p, smem, 1, ctrs + 96))
  xcd_barrier(gbar);
  RUN(19, ln1_phase<bf16>(p, x1b, ybuf, p.ln_gain + 3072, p.ln_bias + 3072, p.out, nullptr))
}

extern "C" void kernel_launch(void* const* d_in, const int* in_sizes, int n_in, void* d_out, int out_size, void* d_ws, size_t ws_size,
                              hipStream_t stream) {
  static int grid_blocks = 0;
  if (!grid_blocks) {
    int dev = 0, cus = 0, per_cu = 0;
    (void)hipGetDevice(&dev);
    (void)hipDeviceGetAttribute(&cus, hipDeviceAttributeMultiprocessorCount, dev);
    (void)hipOccupancyMaxActiveBlocksPerMultiprocessor(&per_cu, fwd_megakernel, 256, 0);
    if (per_cu > 2) per_cu = 2;
    if (per_cu < 1) per_cu = 1;
    grid_blocks = cus * per_cu;
  }
  Params p;
  memset(&p, 0, sizeof(p));
  p.x = (const float*)d_in[0];
  p.mla_w_in = (const float*)d_in[1];
  p.mla_q_norm = (const float*)d_in[2];
  p.mla_kv_norm = (const float*)d_in[3];
  p.mla_w_uq = (const float*)d_in[4];
  p.mla_w_ukv = (const float*)d_in[5];
  p.mla_w_o = (const float*)d_in[6];
  p.dsa_w_in = (const float*)d_in[7];
  p.dsa_w_o = (const float*)d_in[8];
  p.peer_w_q = (const float*)d_in[9];
  p.peer_sub_keys = (const float*)d_in[10];
  p.peer_w_down = (const float*)d_in[11];
  p.peer_w_up = (const float*)d_in[12];
  p.ln_gain = (const float*)d_in[13];
  p.ln_bias = (const float*)d_in[14];
  p.out = (float*)d_out;
  p.ws = (unsigned char*)d_ws;
  for (int i = 0; i < 32; ++i) p.inv64[i] = powf(10000.0f, -((float)(2 * i) / 64.0f));
  for (int i = 0; i < 64; ++i) p.inv128[i] = powf(10000.0f, -((float)(2 * i) / 128.0f));
  (void)hipMemsetAsync((unsigned char*)d_ws + OFF_BAR, 0, XCD_BAR_WORDS * 4, stream);
  void* args[] = {&p};
  hipError_t e = hipLaunchCooperativeKernel((void*)fwd_megakernel, dim3(grid_blocks), dim3(256), args, 0, stream);
  if (e != hipSuccess) fprintf(stderr, "cooperative launch failed: %s (grid %d)\n", hipGetErrorString(e), grid_blocks);
}
```

```cpp
#include <hip/hip_runtime.h>
#include <hip/hip_cooperative_groups.h>
#include <cstdio>
#include <cmath>
#include <cstring>
namespace cg = cooperative_groups;

#define DI __device__ __forceinline__
typedef __attribute__((ext_vector_type(8))) short bf16x8;
typedef __attribute__((ext_vector_type(4))) short s16x4;
typedef __attribute__((ext_vector_type(16))) float f32x16;
typedef __attribute__((ext_vector_type(2))) __bf16 bf2;
typedef __attribute__((ext_vector_type(2))) float f2;
typedef unsigned short bf16;
typedef unsigned int u32;
typedef unsigned long long u64;
typedef __attribute__((ext_vector_type(4))) u32 u32x4;

#define MFMA(a, b, c) __builtin_amdgcn_mfma_f32_32x32x16_bf16((a), (b), (c), 0, 0, 0)

constexpr int T_TOK = 16384;
constexpr int SEQ = 2048;
constexpr float DN_ALPHA = 1.4142135623730951f;
constexpr size_t MB = 1ull << 20;

constexpr size_t OFF_WDOWN = 0;
constexpr size_t OFF_WUP   = 64 * MB;
constexpr size_t OFF_X2F   = 128 * MB;
constexpr size_t OFF_XB    = 192 * MB;
constexpr size_t OFF_VT    = 224 * MB;
constexpr size_t OFF_Q     = 256 * MB;
constexpr size_t OFF_K     = 304 * MB;
constexpr size_t OFF_M     = 256 * MB;
constexpr size_t OFF_HB    = 352 * MB;
constexpr size_t OFF_MASK  = 372 * MB;
constexpr size_t OFF_EX    = 376 * MB;
constexpr size_t OFF_GT    = 384 * MB;
constexpr size_t OFF_HGP   = 440 * MB;
constexpr size_t OFF_CTR   = 448 * MB;
constexpr size_t OFF_RSD   = 450 * MB;
constexpr size_t OFF_RSU   = 451 * MB;
constexpr size_t OFF_SD    = 452 * MB;
constexpr size_t OFF_RSS   = 460 * MB;
constexpr size_t OFF_BAR   = 449 * MB;
constexpr size_t OFF_YB    = 256 * MB;
constexpr size_t OFF_QI    = 392 * MB;
constexpr size_t OFF_KI    = 408 * MB;
constexpr size_t OFF_WI    = 410 * MB;
constexpr size_t OFF_WTS   = 411 * MB;
constexpr size_t OFF_WIN_T  = OFF_WTS;
constexpr size_t OFF_WUQ_T  = OFF_WIN_T + 768 * 1024 * 2;
constexpr size_t OFF_WUKV_T = OFF_WUQ_T + 1536 * 384 * 2;
constexpr size_t OFF_WO_T   = OFF_WUKV_T + 2048 * 256 * 2;
constexpr size_t OFF_DIN_T  = OFF_WO_T + 1024 * 1024 * 2;
constexpr size_t OFF_DO_T   = OFF_DIN_T + 3712 * 1024 * 2;
constexpr size_t OFF_WQ_T   = OFF_DO_T + 1024 * 1024 * 2;
constexpr size_t OFF_SUBK   = OFF_WQ_T + 2 * 2048 * 1024 * 2;
constexpr size_t OFF_TAB64  = OFF_SUBK + 524288 * 2;
constexpr size_t OFF_TAB128 = OFF_TAB64 + 2048 * 32 * 8;

struct Params {
  const float *x, *mla_w_in, *mla_q_norm, *mla_kv_norm, *mla_w_uq, *mla_w_ukv, *mla_w_o, *dsa_w_in, *dsa_w_o,
      *peer_w_q, *peer_sub_keys, *peer_w_down, *peer_w_up, *ln_gain, *ln_bias;
  float* out;
  unsigned char* ws;
  float inv64[32];
  float inv128[64];
};

constexpr int SCROW = 2112;
constexpr int SMEM_BYTES = 8 * SCROW * 4;
#ifndef PH
#define PH 0xFFFFF
#endif
#ifndef REPM
#define REPM 0
#endif
#define RUN(k, ...) if (PH & (1 << k)) { __VA_ARGS__; if (REPM & (1 << k)) { xcd_barrier(gbar); __VA_ARGS__; } }

DI u32 pack2(float a, float b) {
  f2 v = {a, b};
  bf2 r = __builtin_convertvector(v, bf2);
  return __builtin_bit_cast(u32, r);
}
DI bf16 f2bf(float a) { return (bf16)(pack2(a, 0.f) & 0xffffu); }
DI float bflo(u32 u) { return __uint_as_float(u << 16); }
DI float bfhi(u32 u) { return __uint_as_float(u & 0xffff0000u); }
DI u32 sortable(float f) { u32 u = __float_as_uint(f); return u ^ ((u >> 31) ? 0xFFFFFFFFu : 0x80000000u); }
DI float unsortable(u32 k) { u32 u = k ^ ((k >> 31) ? 0x80000000u : 0xFFFFFFFFu); return __uint_as_float(u); }
DI int crow(int i, int g) { return (i & 3) + 8 * (i >> 2) + 4 * g; }
DI float wave_sum(float v) {
  v += __shfl_xor(v, 32); v += __shfl_xor(v, 16); v += __shfl_xor(v, 8);
  v += __shfl_xor(v, 4); v += __shfl_xor(v, 2); v += __shfl_xor(v, 1);
  return v;
}
DI int opaque_tid() { int t = threadIdx.x; asm volatile("" : "+v"(t)); return t; }
DI int wave_sum_i(int v) {
  v += __shfl_xor(v, 32); v += __shfl_xor(v, 16); v += __shfl_xor(v, 8);
  v += __shfl_xor(v, 4); v += __shfl_xor(v, 2); v += __shfl_xor(v, 1);
  return v;
}
DI void cnt_ge_u(int& cnt, u32 a, u32 b) { asm("v_cmp_ge_u32 vcc, %1, %2\n\tv_addc_co_u32 %0, vcc, 0, %0, vcc" : "+v"(cnt) : "v"(a), "v"(b) : "vcc"); }
DI int ballot_cnt_ge(u32 a, u32 b) {
  int t;
  asm volatile("v_cmp_ge_u32 vcc, %1, %2\n\ts_bcnt1_i32_b64 %0, vcc" : "=s"(t) : "v"(a), "v"(b) : "vcc", "scc");
  return t;
}
template <int NJ>
DI u32 bisect256(const u32* row, int lane, int nw, int& cge) {
  u32 v[NJ];
#pragma unroll
  for (int j = 0; j < NJ; ++j) v[j] = (j < nw) ? row[j * 66 + lane + (lane >> 5)] : 0u;
  u32 Tt = 0u;
  for (int bit = 31; bit >= 0; --bit) {
    const u32 cand = Tt | (1u << bit);
    int cnt = 0;
#pragma unroll
    for (int j = 0; j < NJ; ++j) cnt += ballot_cnt_ge(v[j], cand);
    if (cnt >= 256) Tt = cand;
  }
  cge = 0;
#pragma unroll
  for (int j = 0; j < NJ; ++j) cge += ballot_cnt_ge(v[j], Tt);
  return Tt;
}
DI int cmp_ge_u(u32 a, u32 b) { int r; asm("v_cmp_ge_u32 vcc, %1, %2\n\tv_cndmask_b32 %0, 0, 1, vcc" : "=v"(r) : "v"(a), "v"(b) : "vcc"); return r; }
DI int cmp_gt_u(u32 a, u32 b) { int r; asm("v_cmp_gt_u32 vcc, %1, %2\n\tv_cndmask_b32 %0, 0, 1, vcc" : "=v"(r) : "v"(a), "v"(b) : "vcc"); return r; }
DI int cmp_eq_u(u32 a, u32 b) { int r; asm("v_cmp_eq_u32 vcc, %1, %2\n\tv_cndmask_b32 %0, 0, 1, vcc" : "=v"(r) : "v"(a), "v"(b) : "vcc"); return r; }
DI void ins16(u32 (&L)[16], u32 v) {
#pragma unroll
  for (int j = 0; j < 16; ++j) { u32 hi = max(L[j], v); v = min(L[j], v); L[j] = hi; }
}

DI void sincos_d(float angf, float& c, float& s) {
  double x = (double)angf;
  double n = __builtin_rint(x * 0.63661977236758134);
  double rr = __builtin_fma(-n, 1.5707963267948966, x);
  rr = __builtin_fma(-n, 6.123233995736766e-17, rr);
  int q = ((int)n) & 3;
  double r2 = rr * rr;
  double sp = rr * (1.0 + r2 * (-1.0 / 6 + r2 * (1.0 / 120 + r2 * (-1.0 / 5040 + r2 * (1.0 / 362880 + r2 * (-1.0 / 39916800 + r2 * (1.0 / 6227020800.0)))))));
  double cp = 1.0 + r2 * (-0.5 + r2 * (1.0 / 24 + r2 * (-1.0 / 720 + r2 * (1.0 / 40320 + r2 * (-1.0 / 3628800 + r2 * (1.0 / 479001600 + r2 * (-1.0 / 87178291200.0)))))));
  float sf = (float)sp, cf = (float)cp;
  if (q == 0) { c = cf; s = sf; }
  else if (q == 1) { c = -sf; s = cf; }
  else if (q == 2) { c = -cf; s = -sf; }
  else { c = sf; s = -cf; }
}

#define XB_TMO      128
#define XB_XCNT(j)  (256  + 64 * (j))
#define XB_XSUB(j)  (1280 + 64 * (j))
#define XB_XGEN(j)  (2304 + 64 * (j))
#define XB_TOP      3328
#define XB_TOPGEN   3392
#define XCD_BAR_WORDS 3456
#define XB_SPIN_CAP (1u << 20)
#define LAS __attribute__((address_space(3)))
DI unsigned xb_ld(unsigned* p)              { return __hip_atomic_load(p, __ATOMIC_RELAXED, __HIP_MEMORY_SCOPE_AGENT); }
DI unsigned xb_add(unsigned* p, unsigned v) { return __hip_atomic_fetch_add(p, v, __ATOMIC_RELAXED, __HIP_MEMORY_SCOPE_AGENT); }
DI unsigned xb_xcc_id() { return (unsigned)__builtin_amdgcn_s_getreg((3 << 11) | 20) & 0xFu; }
#define XB_SPIN(cond, bar) do { unsigned _sp = 0; while (cond) { __builtin_amdgcn_s_sleep(4); \
    if ((++_sp & 255u) == 0u) { if (xb_ld(&(bar)[XB_TMO])) break; if (_sp > XB_SPIN_CAP) { atomicAdd(&(bar)[XB_TMO], 1u); break; } } } } while (0)
struct XcdBarrier { unsigned* bar; unsigned x; volatile LAS unsigned* st; };
DI XcdBarrier xcd_barrier_post(unsigned* bar, volatile LAS unsigned* st) {
  XcdBarrier b; b.bar = bar; b.x = xb_xcc_id(); b.st = st;
  if (threadIdx.x == 0) (void)xb_add(&bar[XB_XCNT(b.x)], 1u);
  return b;
}
DI void xcd_barrier_complete(unsigned* bar, unsigned x, unsigned& nloc, unsigned& nx) {
  const unsigned G = gridDim.x * gridDim.y * gridDim.z;
  unsigned sum, cnt, mine, sp = 0u;
  for (;;) {
    sum = 0u; cnt = 0u; mine = 0u;
#pragma unroll
    for (unsigned j = 0; j < 16; ++j) { const unsigned c = xb_ld(&bar[XB_XCNT(j)]); sum += c; cnt += (c > 0u) ? 1u : 0u; mine = (j == x) ? c : mine; }
    if (sum == G) break;
    __builtin_amdgcn_s_sleep(1);
    if ((++sp & 255u) == 0u) { if (xb_ld(&bar[XB_TMO])) break; if (sp > XB_SPIN_CAP) { atomicAdd(&bar[XB_TMO], 1u); break; } }
  }
  nloc = mine > 0u ? mine : 1u; nx = cnt > 0u ? cnt : 1u;
}
DI void xcd_barrier(const XcdBarrier& b) {
  asm volatile("s_waitcnt vmcnt(0)" ::: "memory");
  __syncthreads();
  if (threadIdx.x == 0) {
    unsigned* bar = b.bar;
    __builtin_amdgcn_s_waitcnt(0);
    unsigned nloc = b.st[0], nx = b.st[1];
    if (nloc == 0u) { xcd_barrier_complete(bar, b.x, nloc, nx); b.st[0] = nloc; b.st[1] = nx; }
    const unsigned old = xb_add(&bar[XB_XSUB(b.x)], 1u);
    const unsigned gen = old / nloc;
    if (old + 1u == (gen + 1u) * nloc) {
      __builtin_amdgcn_fence(__ATOMIC_RELEASE, "agent");
      asm volatile("s_waitcnt vmcnt(0)" ::: "memory");
      const unsigned og = xb_add(&bar[XB_TOP], 1u);
      const unsigned tg = og / nx;
      if (og + 1u == (tg + 1u) * nx) xb_add(&bar[XB_TOPGEN], 1u);
      else XB_SPIN(xb_ld(&bar[XB_TOPGEN]) == tg, bar);
      __builtin_amdgcn_fence(__ATOMIC_ACQUIRE, "agent");
      xb_add(&bar[XB_XGEN(b.x)], 1u);
      asm volatile("s_waitcnt vmcnt(0)" ::: "memory");
    } else {
      XB_SPIN(xb_ld(&bar[XB_XGEN(b.x)]) == gen, bar);
      __builtin_amdgcn_fence(__ATOMIC_ACQUIRE, "agent");
      asm volatile("s_waitcnt vmcnt(0)" ::: "memory");
    }
  }
  __syncthreads();
}

DI void convert_job(const float* __restrict__ src, bf16* __restrict__ dst, size_t n) {
  size_t n4 = n >> 2;
  for (size_t i = (size_t)blockIdx.x * 256 + threadIdx.x; i < n4; i += (size_t)gridDim.x * 256) {
    float4 v = ((const float4*)src)[i];
    uint2 o; o.x = pack2(v.x, v.y); o.y = pack2(v.z, v.w);
    ((uint2*)dst)[i] = o;
  }
}

DI void fp8_rows(const float* __restrict__ src, unsigned char* __restrict__ dst, float* __restrict__ rs, int nrows) {
  const int lane = threadIdx.x & 63, w = threadIdx.x >> 6;
  for (int row = blockIdx.x * 4 + w; row < nrows; row += gridDim.x * 4) {
    float4 v[4];
    float am = 0.f;
#pragma unroll
    for (int i = 0; i < 4; ++i) {
      v[i] = *(const float4*)(src + (size_t)row * 1024 + 4 * lane + 256 * i);
      am = fmaxf(am, fmaxf(fmaxf(fabsf(v[i].x), fabsf(v[i].y)), fmaxf(fabsf(v[i].z), fabsf(v[i].w))));
    }
    am = fmaxf(am, __shfl_xor(am, 32)); am = fmaxf(am, __shfl_xor(am, 16)); am = fmaxf(am, __shfl_xor(am, 8));
    am = fmaxf(am, __shfl_xor(am, 4)); am = fmaxf(am, __shfl_xor(am, 2)); am = fmaxf(am, __shfl_xor(am, 1));
    const float sc = am > 0.f ? 440.f / am : 1.f;
    if (lane == 0) rs[row] = am > 0.f ? am / 440.f : 1.f;
#pragma unroll
    for (int i = 0; i < 4; ++i) {
      int pk = __builtin_amdgcn_cvt_pk_fp8_f32(v[i].x * sc, v[i].y * sc, 0, false);
      pk = __builtin_amdgcn_cvt_pk_fp8_f32(v[i].z * sc, v[i].w * sc, pk, true);
      *(int*)(dst + (size_t)row * 1024 + 4 * lane + 256 * i) = pk;
    }
  }
}

DI void transpose_job(const float* __restrict__ src, int K, int N, int Npad, bf16* __restrict__ dst, const float* __restrict__ gain, float* tile) {
  const int tid = opaque_tid();
  const int kt_n = K / 64, nt_n = Npad / 64;
  for (int t = blockIdx.x; t < kt_n * nt_n; t += gridDim.x) {
    const int kt = t % kt_n, nt = t / kt_n;
    __syncthreads();
#pragma unroll
    for (int i = 0; i < 4; ++i) {
      int k = (tid >> 4) + 16 * i;
      int n = nt * 64 + (tid & 15) * 4;
      float4 v = make_float4(0.f, 0.f, 0.f, 0.f);
      if (n < N) v = *(const float4*)(src + (size_t)(kt * 64 + k) * N + n);
      float gn = gain ? gain[kt * 64 + k] : 1.f;
      float* tp = tile + k * 65 + (tid & 15) * 4;
      tp[0] = v.x * gn; tp[1] = v.y * gn; tp[2] = v.z * gn; tp[3] = v.w * gn;
    }
    __syncthreads();
#pragma unroll
    for (int i = 0; i < 2; ++i) {
      int n = (tid >> 3) + 32 * i;
      int kc = (tid & 7) * 8;
      float f[8];
#pragma unroll
      for (int j = 0; j < 8; ++j) f[j] = tile[(kc + j) * 65 + n];
      uint4 o; o.x = pack2(f[0], f[1]); o.y = pack2(f[2], f[3]); o.z = pack2(f[4], f[5]); o.w = pack2(f[6], f[7]);
      *(uint4*)(dst + (size_t)(nt * 64 + n) * K + kt * 64 + kc) = o;
    }
  }
}

DI void prep_phase(const Params& p, unsigned char* smem) {
  unsigned char* ws = p.ws;
  float* tile = (float*)smem;
  convert_job(p.x, (bf16*)(ws + OFF_XB), (size_t)T_TOK * 1024);
  convert_job(p.peer_sub_keys, (bf16*)(ws + OFF_SUBK), 524288);
  transpose_job(p.mla_w_in, 1024, 704, 768, (bf16*)(ws + OFF_WIN_T), nullptr, tile);
  transpose_job(p.mla_w_uq, 384, 1536, 1536, (bf16*)(ws + OFF_WUQ_T), p.mla_q_norm, tile);
  transpose_job(p.mla_w_ukv, 256, 2048, 2048, (bf16*)(ws + OFF_WUKV_T), p.mla_kv_norm, tile);
  transpose_job(p.mla_w_o, 1024, 1024, 1024, (bf16*)(ws + OFF_WO_T), nullptr, tile);
  transpose_job(p.dsa_w_in, 1024, 3656, 3712, (bf16*)(ws + OFF_DIN_T), nullptr, tile);
  transpose_job(p.dsa_w_o, 1024, 1024, 1024, (bf16*)(ws + OFF_DO_T), nullptr, tile);
  transpose_job(p.peer_w_q, 1024, 2048, 2048, (bf16*)(ws + OFF_WQ_T), nullptr, tile);
  transpose_job(p.peer_w_q + (size_t)1024 * 2048, 1024, 2048, 2048, (bf16*)(ws + OFF_WQ_T) + (size_t)2048 * 1024, nullptr, tile);
  if (blockIdx.x == 0) ((u32*)(ws + OFF_CTR))[threadIdx.x] = 0u;
  float2* t64 = (float2*)(ws + OFF_TAB64);
  float2* t128 = (float2*)(ws + OFF_TAB128);
  for (int i = blockIdx.x * 256 + threadIdx.x; i < 2048 * 96; i += gridDim.x * 256) {
    int pos = i / 96, f = i % 96;
    float inv = f < 32 ? p.inv64[f] : p.inv128[f - 32];
    float ang = (float)pos * inv;
    float c, s;
    sincos_d(ang, c, s);
    if (f < 32) t64[pos * 32 + f] = make_float2(c, s);
    else t128[pos * 64 + (f - 32)] = make_float2(c, s);
  }
}

constexpr int LDT = 72;

struct GTile { u32x4 a0, a1, a2, a3, b0, b1, b2, b3; };
DI void gt_load(GTile& t, const bf16* ap, const bf16* bp, int lda, int ldb, int k) {
  const bf16* a2 = ap + k;
  const bf16* b2 = bp + k;
  t.a0 = *(const u32x4*)(a2); t.a1 = *(const u32x4*)(a2 + (size_t)32 * lda); t.a2 = *(const u32x4*)(a2 + (size_t)64 * lda); t.a3 = *(const u32x4*)(a2 + (size_t)96 * lda);
  t.b0 = *(const u32x4*)(b2); t.b1 = *(const u32x4*)(b2 + (size_t)32 * ldb); t.b2 = *(const u32x4*)(b2 + (size_t)64 * ldb); t.b3 = *(const u32x4*)(b2 + (size_t)96 * ldb);
}
DI void gt_store(const GTile& t, bf16* asw, bf16* bsw) {
  *(u32x4*)(asw) = t.a0; *(u32x4*)(asw + 32 * LDT) = t.a1; *(u32x4*)(asw + 64 * LDT) = t.a2; *(u32x4*)(asw + 96 * LDT) = t.a3;
  *(u32x4*)(bsw) = t.b0; *(u32x4*)(bsw + 32 * LDT) = t.b1; *(u32x4*)(bsw + 64 * LDT) = t.b2; *(u32x4*)(bsw + 96 * LDT) = t.b3;
}
DI void gt_compute(const bf16* asr, const bf16* bsr, f32x16& acc0, f32x16& acc1, f32x16& acc2, f32x16& acc3) {
  bf16x8 a[4], b0[4], b1[4], b2[4], b3[4];
#pragma unroll
  for (int kk = 0; kk < 4; ++kk) {
    a[kk] = *(const bf16x8*)(asr + kk * 16);
    b0[kk] = *(const bf16x8*)(bsr + kk * 16);
    b1[kk] = *(const bf16x8*)(bsr + 32 * LDT + kk * 16);
    b2[kk] = *(const bf16x8*)(bsr + 64 * LDT + kk * 16);
    b3[kk] = *(const bf16x8*)(bsr + 96 * LDT + kk * 16);
  }
  __builtin_amdgcn_sched_barrier(0);
  __builtin_amdgcn_s_setprio(2);
#pragma unroll
  for (int kk = 0; kk < 4; ++kk) {
    acc0 = MFMA(a[kk], b0[kk], acc0); acc1 = MFMA(a[kk], b1[kk], acc1); acc2 = MFMA(a[kk], b2[kk], acc2); acc3 = MFMA(a[kk], b3[kk], acc3);
  }
  __builtin_amdgcn_s_setprio(0);
  __builtin_amdgcn_sched_barrier(0);
}
DI void gemm_mainloop(const bf16* __restrict__ A, int lda, const bf16* __restrict__ Bt, int ldb, int K, int m0, int n0,
                      bf16* As, bf16* Bs, f32x16& acc0, f32x16& acc1, f32x16& acc2, f32x16& acc3) {
  const int tid = opaque_tid(), lane = tid & 63, w = tid >> 6, r = lane & 31, g = lane >> 5;
  const int lrow = tid >> 3, lcc = (tid & 7) * 8;
  const bf16* ap = A + (size_t)(m0 + lrow) * lda + lcc;
  const bf16* bp = Bt + (size_t)(n0 + lrow) * ldb + lcc;
  GTile t0, t1;
  asm volatile("" ::: "memory");
  const int nkt = K >> 6;
  int kb = ((((m0 >> 7) * 5 + (n0 >> 7) * 3) >> 1) % nkt) << 6;
#define KW(off) ((kb + (off)) >= K ? (kb + (off)) - K : (kb + (off)))
  gt_load(t0, ap, bp, lda, ldb, KW(0));
  gt_load(t1, ap, bp, lda, ldb, KW(64));
#pragma unroll
  for (int i = 0; i < 16; ++i) { acc0[i] = 0.f; acc1[i] = 0.f; acc2[i] = 0.f; acc3[i] = 0.f; }
  bf16* asw = As + lrow * LDT + lcc;
  bf16* bsw = Bs + lrow * LDT + lcc;
  const bf16* asr = As + (32 * w + r) * LDT + g * 8;
  const bf16* bsr = Bs + r * LDT + g * 8;
  for (int k0 = 0; k0 < K; k0 += 128) {
    __syncthreads();
    gt_store(t0, asw, bsw);
    __syncthreads();
    if (k0 + 128 < K) gt_load(t0, ap, bp, lda, ldb, KW(k0 + 128));
    gt_compute(asr, bsr, acc0, acc1, acc2, acc3);
    __syncthreads();
    gt_store(t1, asw, bsw);
    __syncthreads();
    if (k0 + 192 < K) gt_load(t1, ap, bp, lda, ldb, KW(k0 + 192));
    gt_compute(asr, bsr, acc0, acc1, acc2, acc3);
  }
#undef KW
}

DI void row_rms(const bf16* __restrict__ A, int lda, int kc, int m0, float* rs) {
  const int tid = opaque_tid(), lane = tid & 63, w = tid >> 6, r = lane & 31, g = lane >> 5;
  for (int it = 0; it < 16; ++it) {
    int row = 32 * w + 2 * it + g;
    const bf16* rp = A + (size_t)(m0 + row) * lda;
    float ss = 0.f;
    for (int c = r; c < kc / 8; c += 32) {
      uint4 v = *(const uint4*)(rp + c * 8);
      float a0 = bflo(v.x), a1 = bfhi(v.x), a2 = bflo(v.y), a3 = bfhi(v.y), a4 = bflo(v.z), a5 = bfhi(v.z), a6 = bflo(v.w), a7 = bfhi(v.w);
      ss += a0 * a0 + a1 * a1 + a2 * a2 + a3 * a3 + a4 * a4 + a5 * a5 + a6 * a6 + a7 * a7;
    }
    ss += __shfl_xor(ss, 16); ss += __shfl_xor(ss, 8); ss += __shfl_xor(ss, 4); ss += __shfl_xor(ss, 2); ss += __shfl_xor(ss, 1);
    if (r == 0) rs[row] = rsqrtf(ss / (float)kc + 1e-6f);
  }
}

enum { EPI_MLA_IN = 0, EPI_MLA_Q, EPI_MLA_KV, EPI_F32, EPI_PEER, EPI_DSA_IN };

template <int EPI, int HOT = 0>
DI void gemm_phase(const Params& p, unsigned char* smem, const bf16* __restrict__ A, int lda, const bf16* __restrict__ Bt, int K, int Ntiles, int layer) {
  unsigned char* ws = p.ws;
  bf16* As = (bf16*)smem;
  bf16* Bs = As + 128 * LDT;
  float* rs = (float*)(smem + 40960);
  const int tid = opaque_tid(), lane = tid & 63, w = tid >> 6, r = lane & 31, g = lane >> 5;
  const int ntot = 128 * Ntiles;
  int t_start = blockIdx.x, t_step = gridDim.x, t_total = ntot, cntS = 0, xi = 0;
  if constexpr (EPI == EPI_DSA_IN) {
    int* sl = (int*)(smem + 40960);
    __syncthreads();
    if (tid == 0) {
      unsigned* bar = (unsigned*)(ws + OFF_BAR);
      const unsigned myx = xb_xcc_id();
      int nx = 0, xo = 0, nloc = 1;
      for (unsigned j = 0; j < 16; ++j) { const unsigned cj = xb_ld(&bar[XB_XCNT(j)]); if (cj > 0u) { if (j == myx) { xo = nx; nloc = (int)cj; } ++nx; } }
      sl[0] = (int)atomicAdd((u32*)(ws + OFF_CTR) + 128 + myx, 1u);
      sl[1] = nloc; sl[2] = xo; sl[3] = nx;
    }
    __syncthreads();
    if (sl[3] == 8) {
      xi = sl[2];
      cntS = (Ntiles - 1 - xi) / 8 + 1;
      t_start = sl[0]; t_step = sl[1]; t_total = 128 * cntS;
    }
    __syncthreads();
  }
  for (int tile = t_start; tile < t_total; tile += t_step) {
    int mt, nt;
    if (cntS) { mt = tile / cntS; nt = xi + 8 * (tile % cntS); } else { mt = tile / Ntiles; nt = tile % Ntiles; }
    const int m0 = mt * 128, n0 = nt * 128;
    if (EPI == EPI_MLA_Q || EPI == EPI_MLA_KV) {
      __syncthreads();
      if (tid < 128) {
        const float* rp = (const float*)(ws + OFF_RSS) + (size_t)(m0 + tid) * 8;
        const float ssq = (EPI == EPI_MLA_Q) ? ((rp[0] + rp[1]) + rp[2]) : (rp[3] + rp[4]);
        rs[tid] = rsqrtf(ssq / (float)K + 1e-6f);
      }
    }
    f32x16 acc[4];
    gemm_mainloop(A, lda, Bt, K, K, m0, n0, As, Bs, acc[0], acc[1], acc[2], acc[3]);
    if (HOT && acc[0][0] + acc[1][1] + acc[2][2] + acc[3][3] != 12345.678f) continue;
    const int bidx = m0 >> 11;
    const int s0 = (m0 & 2047) + 32 * w;
    if constexpr (EPI == EPI_F32) {
      float* C = (float*)(ws + OFF_M);
#pragma unroll
      for (int j = 0; j < 4; ++j)
#pragma unroll
        for (int i = 0; i < 16; ++i) C[(size_t)(m0 + 32 * w + crow(i, g)) * 1024 + n0 + 32 * j + r] = acc[j][i];
    } else if constexpr (EPI == EPI_MLA_IN) {
      bf16* hb = (bf16*)(ws + OFF_HB);
      if (nt < 5) {
#pragma unroll
        for (int j = 0; j < 4; ++j)
#pragma unroll
          for (int i = 0; i < 16; ++i) hb[(size_t)(m0 + 32 * w + crow(i, g)) * 640 + n0 + 32 * j + r] = f2bf(acc[j][i]);
        float* rss = (float*)(ws + OFF_RSS);
#pragma unroll
        for (int i = 0; i < 16; ++i) {
          float ss = acc[0][i] * acc[0][i] + acc[1][i] * acc[1][i] + acc[2][i] * acc[2][i] + acc[3][i] * acc[3][i];
          ss += __shfl_xor(ss, 16); ss += __shfl_xor(ss, 8); ss += __shfl_xor(ss, 4); ss += __shfl_xor(ss, 2); ss += __shfl_xor(ss, 1);
          if (r == 0) rss[(size_t)(m0 + 32 * w + crow(i, g)) * 8 + nt] = ss;
        }
      } else {
        const float2* t64 = (const float2*)(ws + OFF_TAB64);
        bf16* Kb = (bf16*)(ws + OFF_K);
#pragma unroll
        for (int i = 0; i < 16; ++i) {
          int s = s0 + crow(i, g);
          float2 cs = t64[s * 32 + r];
          float x1 = acc[0][i], x2 = acc[1][i];
          bf16 o1 = f2bf(x1 * cs.x - x2 * cs.y), o2 = f2bf(x2 * cs.x + x1 * cs.y);
#pragma unroll
          for (int hh = 0; hh < 8; ++hh) {
            bf16* kp = Kb + ((size_t)(bidx * 8 + hh) * 2048 + s) * 192 + 128;
            kp[r] = o1; kp[32 + r] = o2;
          }
        }
      }
    } else if constexpr (EPI == EPI_MLA_Q) {
      bf16* Qb = (bf16*)(ws + OFF_Q);
      const float2* t64 = (const float2*)(ws + OFF_TAB64);
      __syncthreads();
#pragma unroll
      for (int j = 0; j < 4; ++j) {
        const int n = n0 + 32 * j;
        const int hh = n / 192, d0 = n % 192;
        if (d0 < 128) {
#pragma unroll
          for (int i = 0; i < 16; ++i) {
            int rl = 32 * w + crow(i, g);
            int s = (m0 & 2047) + rl;
            Qb[((size_t)(bidx * 8 + hh) * 2048 + s) * 192 + d0 + r] = f2bf(acc[j][i] * rs[rl]);
          }
        } else if (d0 == 128) {
          if (j < 3) {
#pragma unroll
            for (int i = 0; i < 16; ++i) {
              int rl = 32 * w + crow(i, g);
              int s = (m0 & 2047) + rl;
              float2 cs = t64[s * 32 + r];
              float x1 = acc[j][i] * rs[rl], x2 = acc[(j + 1) & 3][i] * rs[rl];
              bf16* qp = Qb + ((size_t)(bidx * 8 + hh) * 2048 + s) * 192 + 128;
              qp[r] = f2bf(x1 * cs.x - x2 * cs.y);
              qp[32 + r] = f2bf(x2 * cs.x + x1 * cs.y);
            }
          }
        }
      }
    } else if constexpr (EPI == EPI_MLA_KV) {
      __syncthreads();
      const int hh = nt >> 1;
      if ((nt & 1) == 0) {
        bf16* Kb = (bf16*)(ws + OFF_K);
#pragma unroll
        for (int j = 0; j < 4; ++j)
#pragma unroll
          for (int i = 0; i < 16; ++i) {
            int rl = 32 * w + crow(i, g);
            int s = (m0 & 2047) + rl;
            Kb[((size_t)(bidx * 8 + hh) * 2048 + s) * 192 + 32 * j + r] = f2bf(acc[j][i] * rs[rl]);
          }
      } else {
        bf16* Vt = (bf16*)(ws + OFF_VT);
#pragma unroll
        for (int j = 0; j < 4; ++j)
#pragma unroll
          for (int qd = 0; qd < 4; ++qd) {
            int rl = 32 * w + 8 * qd + 4 * g;
            int s = (m0 & 2047) + rl;
            uint2 o;
            o.x = pack2(acc[j][4 * qd] * rs[rl], acc[j][4 * qd + 1] * rs[rl + 1]);
            o.y = pack2(acc[j][4 * qd + 2] * rs[rl + 2], acc[j][4 * qd + 3] * rs[rl + 3]);
            *(uint2*)(Vt + (((size_t)(bidx * 8 + hh) * 32 + (s >> 6)) * 128 + 32 * j + r) * 64 + (s & 63)) = o;
          }
      }
    } else if constexpr (EPI == EPI_DSA_IN) {
      const float2* t64 = (const float2*)(ws + OFF_TAB64);
      const float2* t128 = (const float2*)(ws + OFF_TAB128);
      if (nt < 16) {
        bf16* dst = (bf16*)(ws + (nt < 8 ? OFF_Q : OFF_K));
        const int hh = nt & 7;
#pragma unroll
        for (int j = 0; j < 2; ++j)
#pragma unroll
          for (int i = 0; i < 16; ++i) {
            int s = s0 + crow(i, g);
            int d = 32 * j + r;
            float2 cs = t128[s * 64 + d];
            float x1 = acc[j][i], x2 = acc[j + 2][i];
            bf16* qp = dst + ((size_t)(bidx * 8 + hh) * 2048 + s) * 128;
            qp[d] = f2bf(x1 * cs.x - x2 * cs.y);
            qp[d + 64] = f2bf(x2 * cs.x + x1 * cs.y);
          }
      } else if (nt < 24) {
        bf16* Vt = (bf16*)(ws + OFF_VT);
        const int hh = nt - 16;
#pragma unroll
        for (int j = 0; j < 4; ++j)
#pragma unroll
          for (int qd = 0; qd < 4; ++qd) {
            int s = s0 + 8 * qd + 4 * g;
            uint2 o;
            o.x = pack2(acc[j][4 * qd], acc[j][4 * qd + 1]);
            o.y = pack2(acc[j][4 * qd + 2], acc[j][4 * qd + 3]);
            *(uint2*)(Vt + (((size_t)(bidx * 8 + hh) * 32 + (s >> 6)) * 128 + 32 * j + r) * 64 + (s & 63)) = o;
          }
      } else if (nt < 28) {
        bf16* qi = (bf16*)(ws + OFF_QI);
#pragma unroll
        for (int jp = 0; jp < 2; ++jp)
#pragma unroll
          for (int i = 0; i < 16; ++i) {
            int rl = 32 * w + crow(i, g);
            int s = (m0 & 2047) + rl;
            float2 cs = t64[s * 32 + r];
            float x1 = acc[2 * jp][i], x2 = acc[2 * jp + 1][i];
            int ih = 2 * (nt - 24) + jp;
            bf16* qp = qi + ((size_t)(m0 + rl) * 8 + ih) * 64;
            qp[r] = f2bf(x1 * cs.x - x2 * cs.y);
            qp[32 + r] = f2bf(x2 * cs.x + x1 * cs.y);
          }
      } else {
        bf16* ki = (bf16*)(ws + OFF_KI);
        float* wi = (float*)(ws + OFF_WI);
#pragma unroll
        for (int i = 0; i < 16; ++i) {
          int rl = 32 * w + crow(i, g);
          int s = (m0 & 2047) + rl;
          float2 cs = t64[s * 32 + r];
          float x1 = acc[0][i], x2 = acc[1][i];
          bf16* kp = ki + (size_t)(m0 + rl) * 64;
          kp[r] = f2bf(x1 * cs.x - x2 * cs.y);
          kp[32 + r] = f2bf(x2 * cs.x + x1 * cs.y);
          if (r < 8) wi[(size_t)(m0 + rl) * 8 + r] = acc[2][i] * 0.044194173824159216f;
        }
      }
    }
  }
}

template <int DQ, bool MASK>
DI void attn_phase(const Params& p, unsigned char* smem, float cexp) {
  unsigned char* ws = p.ws;
  const bf16* Qb = (const bf16*)(ws + OFF_Q);
  const bf16* Kb = (const bf16*)(ws + OFF_K);
  const bf16* Vt = (const bf16*)(ws + OFF_VT);
  const u64* mask = (const u64*)(ws + OFF_MASK);
  bf16* outp = (bf16*)(ws + OFF_XB);
  constexpr int KST = DQ + 8;
  constexpr int VST = 68;
  bf16* Ks = (bf16*)smem;
  bf16* Vs = Ks + 64 * KST;
  const int tid = opaque_tid(), lane = tid & 63, w = tid >> 6, r = lane & 31, g = lane >> 5;
  for (int it = blockIdx.x; it < 1024; it += gridDim.x) {
    const int seg = it >> 9, idx = it & 511, lv = idx >> 6, bh = idx & 63;
    const int qb = seg == 0 ? 15 - lv : lv;
    const int q0 = qb * 128;
    const int ntile_block = 2 * qb + 2, my_nt = 2 * qb + 1 + (w >> 1);
    const int b = bh >> 3, h = bh & 7;
    const size_t tok = (size_t)b * 2048 + q0 + 32 * w + r;
    bf16x8 qf[DQ / 16];
    {
      const bf16* qp = Qb + ((size_t)bh * 2048 + q0 + 32 * w + r) * DQ + 8 * g;
#pragma unroll
      for (int s = 0; s < DQ / 16; ++s) qf[s] = *(const bf16x8*)(qp + 16 * s);
    }
    f32x16 o[4];
#pragma unroll
    for (int j = 0; j < 4; ++j)
#pragma unroll
      for (int i = 0; i < 16; ++i) o[j][i] = 0.f;
    float m = -INFINITY, l = 0.f;
    for (int kt = 0; kt < ntile_block; ++kt) {
      __syncthreads();
      {
        constexpr int CPR = DQ / 8;
#pragma unroll
        for (int i = 0; i < DQ / 32; ++i) {
          int c = tid + 256 * i;
          int row = c / CPR, cc = c % CPR;
          uint4 v = *(const uint4*)(Kb + ((size_t)bh * 2048 + kt * 64 + row) * DQ + cc * 8);
          *(uint4*)(Ks + row * KST + cc * 8) = v;
        }
#pragma unroll
        for (int i = 0; i < 4; ++i) {
          int c = tid + 256 * i;
          int d = c >> 3, cc = c & 7;
          uint4 v = *(const uint4*)(Vt + (((size_t)bh * 32 + kt) * 128 + d) * 64 + cc * 8);
          uint2* dp = (uint2*)(Vs + d * VST + cc * 8);
          dp[0] = make_uint2(v.x, v.y);
          dp[1] = make_uint2(v.z, v.w);
        }
      }
      __syncthreads();
      if (kt < my_nt) {
        f32x16 sa[2];
#pragma unroll
        for (int u = 0; u < 2; ++u) {
#pragma unroll
          for (int i = 0; i < 16; ++i) sa[u][i] = 0.f;
#pragma unroll
          for (int s = 0; s < DQ / 16; ++s) {
            bf16x8 a = *(const bf16x8*)(Ks + (32 * u + r) * KST + 16 * s + 8 * g);
            sa[u] = MFMA(a, qf[s], sa[u]);
          }
        }
        if (MASK) {
          u64 mw = mask[tok * 32 + kt] >> (4 * g);
          const u32 mlo = (u32)mw, mhi = (u32)(mw >> 32);
#pragma unroll
          for (int i = 0; i < 16; ++i) {
            const u32 bit = 1u << ((i & 3) + 8 * (i >> 2));
            if (!(mlo & bit)) sa[0][i] = -INFINITY;
            if (!(mhi & bit)) sa[1][i] = -INFINITY;
          }
        }
        float mx = -INFINITY;
#pragma unroll
        for (int u = 0; u < 2; ++u)
#pragma unroll
          for (int i = 0; i < 16; ++i) mx = fmaxf(mx, sa[u][i]);
        mx = fmaxf(mx, __shfl_xor(mx, 32));
        float mnew = fmaxf(m, mx);
        float muse = (mnew == -INFINITY) ? 0.f : mnew;
        float alpha = __builtin_amdgcn_exp2f((m - muse) * cexp);
        m = mnew;
        float ps = 0.f;
#pragma unroll
        for (int u = 0; u < 2; ++u)
#pragma unroll
          for (int i = 0; i < 16; ++i) {
            float pv = __builtin_amdgcn_exp2f((sa[u][i] - muse) * cexp);
            ps += pv;
            sa[u][i] = pv;
          }
        l = l * alpha + ps;
#pragma unroll
        for (int j = 0; j < 4; ++j)
#pragma unroll
          for (int i = 0; i < 16; ++i) o[j][i] *= alpha;
#pragma unroll
        for (int u = 0; u < 2; ++u)
#pragma unroll
          for (int s2 = 0; s2 < 2; ++s2) {
            uint4 pp;
            pp.x = pack2(sa[u][8 * s2 + 0], sa[u][8 * s2 + 1]);
            pp.y = pack2(sa[u][8 * s2 + 2], sa[u][8 * s2 + 3]);
            pp.z = pack2(sa[u][8 * s2 + 4], sa[u][8 * s2 + 5]);
            pp.w = pack2(sa[u][8 * s2 + 6], sa[u][8 * s2 + 7]);
            bf16x8 pf = __builtin_bit_cast(bf16x8, pp);
#pragma unroll
            for (int dt = 0; dt < 4; ++dt) {
              const bf16* vp = Vs + (32 * dt + r) * VST + 32 * u + 16 * s2 + 4 * g;
              s16x4 lo = *(const s16x4*)vp;
              s16x4 hi = *(const s16x4*)(vp + 8);
              bf16x8 vf = __builtin_shufflevector(lo, hi, 0, 1, 2, 3, 4, 5, 6, 7);
              o[dt] = MFMA(vf, pf, o[dt]);
            }
          }
      }
    }
    float lt = l + __shfl_xor(l, 32);
    float inv = 1.f / lt;
    bf16* op = outp + tok * 1024 + h * 128;
#pragma unroll
    for (int dt = 0; dt < 4; ++dt)
#pragma unroll
      for (int qd = 0; qd < 4; ++qd) {
        uint2 ov;
        ov.x = pack2(o[dt][4 * qd] * inv, o[dt][4 * qd + 1] * inv);
        ov.y = pack2(o[dt][4 * qd + 2] * inv, o[dt][4 * qd + 3] * inv);
        *(uint2*)(op + 32 * dt + 8 * qd + 4 * g) = ov;
      }
  }
}

DI void indexer_phase(const Params& p, unsigned char* smem) {
  unsigned char* ws = p.ws;
  const bf16* qi = (const bf16*)(ws + OFF_QI);
  const bf16* ki = (const bf16*)(ws + OFF_KI);
  const float* wi = (const float*)(ws + OFF_WI);
  u64* mask = (u64*)(ws + OFF_MASK);
  u32* sc = (u32*)smem;
  const int tid = opaque_tid(), lane = tid & 63, w = tid >> 6, r = lane & 31, g = lane >> 5;
  for (int it = blockIdx.x; it < 2048; it += gridDim.x) {
    const int seg = it >> 9, idx = it & 511, j8 = idx >> 6, sub = idx & 63;
    const int chunk = seg == 0 ? 31 - j8 : seg == 1 ? 16 + j8 : seg == 2 ? 15 - j8 : j8;
    const int b = sub >> 3, sl = sub & 7;
    const int tok0 = b * 2048 + chunk * 64 + sl * 8;
    const int n = (chunk + 1) * 64;
    const int nw = chunk + 1;
    if (chunk < 4) {
      int q = tid >> 5, j = tid & 31;
      mask[(size_t)(tok0 + q) * 32 + j] = (j < nw) ? ~0ull : 0ull;
      continue;
    }
    bf16x8 af[2][4];
    float wv[2][2][8];
    {
      const int head = (r & 3) + 4 * ((r >> 3) & 1);
      const int ql = ((r >> 2) & 1) + 2 * (r >> 4);
#pragma unroll
      for (int rt = 0; rt < 2; ++rt) {
        const bf16* ap = qi + ((size_t)(tok0 + 4 * rt + ql) * 8 + head) * 64 + 8 * g;
#pragma unroll
        for (int s = 0; s < 4; ++s) af[rt][s] = *(const bf16x8*)(ap + 16 * s);
#pragma unroll
        for (int qs = 0; qs < 2; ++qs) {
          const float* wp = wi + (size_t)(tok0 + 4 * rt + g + 2 * qs) * 8;
          float4 w0 = *(const float4*)wp, w1 = *(const float4*)(wp + 4);
          wv[rt][qs][0] = w0.x; wv[rt][qs][1] = w0.y; wv[rt][qs][2] = w0.z; wv[rt][qs][3] = w0.w;
          wv[rt][qs][4] = w1.x; wv[rt][qs][5] = w1.y; wv[rt][qs][6] = w1.z; wv[rt][qs][7] = w1.w;
        }
      }
    }
    const int nkt = 2 * (chunk + 1);
    {
      bf16x8 bn0, bn1, bn2, bn3;
      {
        const bf16* kp = ki + ((size_t)(b * 2048 + 32 * w + r)) * 64 + 8 * g;
        bn0 = *(const bf16x8*)(kp); bn1 = *(const bf16x8*)(kp + 16); bn2 = *(const bf16x8*)(kp + 32); bn3 = *(const bf16x8*)(kp + 48);
      }
      for (int kt = w; kt < nkt; kt += 4) {
        const bf16x8 b0 = bn0, b1 = bn1, b2 = bn2, b3 = bn3;
        if (kt + 4 < nkt) {
          const bf16* kp = ki + ((size_t)(b * 2048 + 32 * (kt + 4) + r)) * 64 + 8 * g;
          bn0 = *(const bf16x8*)(kp); bn1 = *(const bf16x8*)(kp + 16); bn2 = *(const bf16x8*)(kp + 32); bn3 = *(const bf16x8*)(kp + 48);
        }
#pragma unroll
        for (int rt = 0; rt < 2; ++rt) {
          f32x16 a;
#pragma unroll
          for (int i = 0; i < 16; ++i) a[i] = 0.f;
          a = MFMA(af[rt][0], b0, a); a = MFMA(af[rt][1], b1, a); a = MFMA(af[rt][2], b2, a); a = MFMA(af[rt][3], b3, a);
          float s0 = 0.f, s1 = 0.f;
#pragma unroll
          for (int i = 0; i < 8; ++i) {
            s0 += wv[rt][0][i] * fmaxf(a[i], 0.f);
            s1 += wv[rt][1][i] * fmaxf(a[8 + i], 0.f);
          }
          sc[(4 * rt + g) * SCROW + 33 * kt + r] = sortable(s0);
          sc[(4 * rt + g + 2) * SCROW + 33 * kt + r] = sortable(s1);
        }
      }
    }
    __syncthreads();
    for (int qq = 0; qq < 2; ++qq) {
      const int ql = 2 * w + qq;
      const u32* row = sc + ql * SCROW;
      u32 Tt;
      int cge;
      if (nw <= 8) Tt = bisect256<8>(row, lane, nw, cge);
      else if (nw <= 16) Tt = bisect256<16>(row, lane, nw, cge);
      else if (nw <= 24) Tt = bisect256<24>(row, lane, nw, cge);
      else Tt = bisect256<32>(row, lane, nw, cge);
      const bool lane_ok = (lane < 2 * nw);
      if (cge == 256) {
        u32 bits = 0u;
#pragma unroll
        for (int jj = 0; jj < 32; ++jj) {
          const u32 val = lane_ok ? row[33 * lane + jj] : 0u;
          bits |= ((u32)cmp_ge_u(val, Tt) << jj);
        }
        ((u32*)mask)[(size_t)(tok0 + ql) * 64 + lane] = bits;
        continue;
      }
      u32 wv2[32];
      int gtc = 0, eqc = 0;
#pragma unroll
      for (int jj = 0; jj < 32; ++jj) {
        u32 val = lane_ok ? row[33 * lane + jj] : 0u;
        wv2[jj] = val;
        gtc += cmp_gt_u(val, Tt);
        eqc += cmp_eq_u(val, Tt);
      }
      const int cgt = wave_sum_i(gtc);
      const int need = 256 - cgt;
      int incl = eqc;
#pragma unroll
      for (int off = 1; off < 64; off <<= 1) { int t = __shfl_up(incl, off); if (lane >= off) incl += t; }
      int rank = incl - eqc;
      u32 bits = 0u;
#pragma unroll
      for (int jj = 0; jj < 32; ++jj) {
        int eq = cmp_eq_u(wv2[jj], Tt);
        int sel = cmp_gt_u(wv2[jj], Tt) | (eq & (int)(((u32)(rank - need)) >> 31));
        rank += eq;
        bits |= ((u32)sel << jj);
      }
      if (!lane_ok) bits = 0u;
      ((u32*)mask)[(size_t)(tok0 + ql) * 64 + lane] = bits;
    }
    __syncthreads();
  }
}

template <typename XT>
DI void ln1_phase(const Params& p, const XT* __restrict__ xin, const float* __restrict__ mm, const float* __restrict__ gain, const float* __restrict__ bias,
                  float* __restrict__ of, bf16* __restrict__ ob) {
  const int tid = opaque_tid(), lane = tid & 63, w = tid >> 6;
  for (int t = blockIdx.x * 4 + w; t < T_TOK; t += gridDim.x * 4) {
    float v[16];
#pragma unroll
    for (int i = 0; i < 4; ++i) {
      float4 a;
      if constexpr (sizeof(XT) == 4) {
        a = *(const float4*)((const float*)xin + (size_t)t * 1024 + 4 * lane + 256 * i);
      } else {
        const uint2 ab = *(const uint2*)((const bf16*)xin + (size_t)t * 1024 + 4 * lane + 256 * i);
        a = make_float4(bflo(ab.x), bfhi(ab.x), bflo(ab.y), bfhi(ab.y));
      }
      float4 c = *(const float4*)(mm + (size_t)t * 1024 + 4 * lane + 256 * i);
      v[4 * i] = DN_ALPHA * a.x + c.x; v[4 * i + 1] = DN_ALPHA * a.y + c.y; v[4 * i + 2] = DN_ALPHA * a.z + c.z; v[4 * i + 3] = DN_ALPHA * a.w + c.w;
    }
    float s = 0.f;
#pragma unroll
    for (int i = 0; i < 16; ++i) s += v[i];
    float mu = wave_sum(s) * (1.f / 1024.f);
    float q = 0.f;
#pragma unroll
    for (int i = 0; i < 16; ++i) { float d = v[i] - mu; q += d * d; }
    float rstd = rsqrtf(wave_sum(q) * (1.f / 1024.f) + 1e-5f);
#pragma unroll
    for (int i = 0; i < 4; ++i) {
      float4 gg = *(const float4*)(gain + 4 * lane + 256 * i);
      float4 bb = *(const float4*)(bias + 4 * lane + 256 * i);
      float4 o;
      o.x = (v[4 * i] - mu) * rstd * gg.x + bb.x; o.y = (v[4 * i + 1] - mu) * rstd * gg.y + bb.y;
      o.z = (v[4 * i + 2] - mu) * rstd * gg.z + bb.z; o.w = (v[4 * i + 3] - mu) * rstd * gg.w + bb.w;
      if (of) *(float4*)(of + (size_t)t * 1024 + 4 * lane + 256 * i) = o;
      if (ob) *(uint2*)(ob + (size_t)t * 1024 + 4 * lane + 256 * i) = make_uint2(pack2(o.x, o.y), pack2(o.z, o.w));
    }
  }
}

DI u32 xcc_id() { return (u32)__builtin_amdgcn_s_getreg((3 << 11) | 20) & 7u; }
DI float fdot2(u32 a, u32 b, float c) { return __builtin_amdgcn_fdot2_f32_bf16(__builtin_bit_cast(bf2, a), __builtin_bit_cast(bf2, b), c, false); }
DI float dot8(u32x4 a, u32x4 b, float acc) {
  acc = fdot2(a.x, b.x, acc); acc = fdot2(a.y, b.y, acc); acc = fdot2(a.z, b.z, acc); acc = fdot2(a.w, b.w, acc);
  return acc;
}

#define CEX(a, b) { const u32 hi_ = max(a, b), lo_ = min(a, b); a = hi_; b = lo_; }
DI void sort16_desc(u32 (&a)[16]) {
  CEX(a[0], a[1])
  CEX(a[3], a[2])
  CEX(a[4], a[5])
  CEX(a[7], a[6])
  CEX(a[8], a[9])
  CEX(a[11], a[10])
  CEX(a[12], a[13])
  CEX(a[15], a[14])
  CEX(a[0], a[2])
  CEX(a[1], a[3])
  CEX(a[6], a[4])
  CEX(a[7], a[5])
  CEX(a[8], a[10])
  CEX(a[9], a[11])
  CEX(a[14], a[12])
  CEX(a[15], a[13])
  CEX(a[0], a[1])
  CEX(a[2], a[3])
  CEX(a[5], a[4])
  CEX(a[7], a[6])
  CEX(a[8], a[9])
  CEX(a[10], a[11])
  CEX(a[13], a[12])
  CEX(a[15], a[14])
  CEX(a[0], a[4])
  CEX(a[1], a[5])
  CEX(a[2], a[6])
  CEX(a[3], a[7])
  CEX(a[12], a[8])
  CEX(a[13], a[9])
  CEX(a[14], a[10])
  CEX(a[15], a[11])
  CEX(a[0], a[2])
  CEX(a[1], a[3])
  CEX(a[4], a[6])
  CEX(a[5], a[7])
  CEX(a[10], a[8])
  CEX(a[11], a[9])
  CEX(a[14], a[12])
  CEX(a[15], a[13])
  CEX(a[0], a[1])
  CEX(a[2], a[3])
  CEX(a[4], a[5])
  CEX(a[6], a[7])
  CEX(a[9], a[8])
  CEX(a[11], a[10])
  CEX(a[13], a[12])
  CEX(a[15], a[14])
  CEX(a[0], a[8])
  CEX(a[1], a[9])
  CEX(a[2], a[10])
  CEX(a[3], a[11])
  CEX(a[4], a[12])
  CEX(a[5], a[13])
  CEX(a[6], a[14])
  CEX(a[7], a[15])
  CEX(a[0], a[4])
  CEX(a[1], a[5])
  CEX(a[2], a[6])
  CEX(a[3], a[7])
  CEX(a[8], a[12])
  CEX(a[9], a[13])
  CEX(a[10], a[14])
  CEX(a[11], a[15])
  CEX(a[0], a[2])
  CEX(a[1], a[3])
  CEX(a[4], a[6])
  CEX(a[5], a[7])
  CEX(a[8], a[10])
  CEX(a[9], a[11])
  CEX(a[12], a[14])
  CEX(a[13], a[15])
  CEX(a[0], a[1])
  CEX(a[2], a[3])
  CEX(a[4], a[5])
  CEX(a[6], a[7])
  CEX(a[8], a[9])
  CEX(a[10], a[11])
  CEX(a[12], a[13])
  CEX(a[14], a[15])
}
DI void merge16_desc(u32 (&a)[16], const u32 (&b)[16]) {
#pragma unroll
  for (int k = 0; k < 16; ++k) a[k] = max(a[k], b[15 - k]);
  CEX(a[0], a[8])
  CEX(a[1], a[9])
  CEX(a[2], a[10])
  CEX(a[3], a[11])
  CEX(a[4], a[12])
  CEX(a[5], a[13])
  CEX(a[6], a[14])
  CEX(a[7], a[15])
  CEX(a[0], a[4])
  CEX(a[1], a[5])
  CEX(a[2], a[6])
  CEX(a[3], a[7])
  CEX(a[8], a[12])
  CEX(a[9], a[13])
  CEX(a[10], a[14])
  CEX(a[11], a[15])
  CEX(a[0], a[2])
  CEX(a[1], a[3])
  CEX(a[4], a[6])
  CEX(a[5], a[7])
  CEX(a[8], a[10])
  CEX(a[9], a[11])
  CEX(a[12], a[14])
  CEX(a[13], a[15])
  CEX(a[0], a[1])
  CEX(a[2], a[3])
  CEX(a[4], a[5])
  CEX(a[6], a[7])
  CEX(a[8], a[9])
  CEX(a[10], a[11])
  CEX(a[12], a[13])
  CEX(a[14], a[15])
}

DI void peer1_phase(const Params& p, unsigned char* smem, const bf16* __restrict__ A, const bf16* __restrict__ Bt, int layer) {
  unsigned char* ws = p.ws;
  bf16* As = (bf16*)smem;
  bf16* Bs = As + 128 * LDT;
  bf16* Qs = (bf16*)smem;
  u32* pkl = (u32*)(smem + 40960);
  int* exo = (int*)(ws + OFF_EX);
  float* gto = (float*)(ws + OFF_GT);
  const int tid = opaque_tid(), lane = tid & 63, w = tid >> 6, r = lane & 31, g = lane >> 5;
  for (int item = blockIdx.x; item < 1024; item += gridDim.x) {
    const int mt = item >> 3, hh = item & 7;
    const int m0 = mt * 128;
    for (int half = 0; half < 2; ++half) {
      const int n0 = (2 * hh + half) * 128;
      f32x16 acc[4];
      gemm_mainloop(A, 1024, Bt, 1024, 1024, m0, n0, As, Bs, acc[0], acc[1], acc[2], acc[3]);
      __syncthreads();
#pragma unroll
      for (int j = 0; j < 4; ++j)
#pragma unroll
        for (int i = 0; i < 16; ++i) Qs[(32 * w + crow(i, g)) * 136 + 32 * j + r] = f2bf(acc[j][i]);
      __syncthreads();
      int sklo = r * 128 + 8 * g;
      asm volatile("" : "+v"(sklo));
      const bf16* sk = (const bf16*)(ws + OFF_SUBK) + (((size_t)layer * 2 + half) * 8 + hh) * 128 * 128 + sklo;
      f32x16 sc[4];
#pragma unroll
      for (int j = 0; j < 4; ++j)
#pragma unroll
        for (int i = 0; i < 16; ++i) sc[j][i] = 0.f;
      {
        bf16x8 skf[8][4];
#pragma unroll
        for (int s = 0; s < 8; ++s)
#pragma unroll
          for (int n4 = 0; n4 < 4; ++n4) skf[s][n4] = *(const bf16x8*)(sk + (32 * n4) * 128 + 16 * s);
        __builtin_amdgcn_sched_barrier(0);
#pragma unroll
        for (int s = 0; s < 8; ++s) {
          bf16x8 bq = *(const bf16x8*)(Qs + (32 * w + r) * 136 + 16 * s + 8 * g);
#pragma unroll
          for (int n4 = 0; n4 < 4; ++n4) sc[n4] = MFMA(skf[s][n4], bq, sc[n4]);
        }
      }
      u32 L[16];
      {
        u32 G1[16], G2[16], G3[16];
#pragma unroll
        for (int i = 0; i < 16; ++i) {
          const int nc = (i & 3) + 8 * (i >> 2);
          L[i]  = (sortable(sc[0][i]) & ~127u) | (u32)(127 - nc);
          G1[i] = (sortable(sc[1][i]) & ~127u) | (u32)(127 - 32 - nc);
          G2[i] = (sortable(sc[2][i]) & ~127u) | (u32)(127 - 64 - nc);
          G3[i] = (sortable(sc[3][i]) & ~127u) | (u32)(127 - 96 - nc);
        }
        sort16_desc(L); sort16_desc(G1); sort16_desc(G2); sort16_desc(G3);
        merge16_desc(L, G1); merge16_desc(G2, G3); merge16_desc(L, G2);
      }
#pragma unroll
      for (int k = 0; k < 16; ++k) L[k] ^= (u32)(g << 2);
      u32 R[16];
#pragma unroll
      for (int k = 0; k < 16; ++k) R[k] = (u32)__shfl_xor((int)L[k], 32);
      merge16_desc(L, R);
      if (g == 0) {
        u32* pk = pkl + (half * 128 + 32 * w + r) * 16;
#pragma unroll
        for (int k4 = 0; k4 < 4; ++k4) *(uint4*)(pk + 4 * k4) = make_uint4(L[4 * k4], L[4 * k4 + 1], L[4 * k4 + 2], L[4 * k4 + 3]);
      }
    }
    __syncthreads();
    if (tid < 128) {
      const u32* p1 = pkl + tid * 16;
      const u32* p2 = pkl + (128 + tid) * 16;
      float v1[16], v2[16];
#pragma unroll
      for (int k4 = 0; k4 < 4; ++k4) {
        uint4 a = *(const uint4*)(p1 + 4 * k4), c = *(const uint4*)(p2 + 4 * k4);
        v1[4 * k4] = unsortable(a.x & ~127u); v1[4 * k4 + 1] = unsortable(a.y & ~127u); v1[4 * k4 + 2] = unsortable(a.z & ~127u); v1[4 * k4 + 3] = unsortable(a.w & ~127u);
        v2[4 * k4] = unsortable(c.x & ~127u); v2[4 * k4 + 1] = unsortable(c.y & ~127u); v2[4 * k4 + 2] = unsortable(c.z & ~127u); v2[4 * k4 + 3] = unsortable(c.w & ~127u);
      }
      u32 L[16];
#pragma unroll
      for (int k = 0; k < 16; ++k) L[k] = 0u;
#pragma unroll
      for (int i = 0; i < 16; ++i)
#pragma unroll
        for (int j = 0; j < 16; ++j)
          if ((i + 1) * (j + 1) <= 16) {
            u32 key = (sortable(v1[i] + v2[j]) & ~255u) | (u32)(255 - (i * 16 + j));
            ins16(L, key);
          }
      float bv[16];
      float mx = unsortable(L[0] & ~255u);
      float sum = 0.f;
#pragma unroll
      for (int k = 0; k < 16; ++k) { bv[k] = __expf(unsortable(L[k] & ~255u) - mx); sum += bv[k]; }
      float isum = 1.f / sum;
      int ev[16];
#pragma unroll
      for (int k = 0; k < 16; ++k) {
        int pos = 255 - (int)(L[k] & 255u);
        int i1 = 127 - (int)(p1[pos >> 4] & 127u);
        int i2 = 127 - (int)(p2[pos & 15] & 127u);
        ev[k] = i1 * 128 + i2;
        bv[k] *= isum;
      }
      int* eo = exo + (size_t)(m0 + tid) * 128 + hh * 16;
      float* go = gto + (size_t)(m0 + tid) * 128 + hh * 16;
      float* so = (float*)(ws + OFF_SD) + (size_t)(m0 + tid) * 128 + hh * 16;
      const float* rsd = (const float*)(ws + OFF_RSD) + layer * 16384;
      const float* rsu = (const float*)(ws + OFF_RSU) + layer * 16384;
      float sdv[16];
#pragma unroll
      for (int k = 0; k < 16; ++k) { bv[k] *= rsu[ev[k]]; sdv[k] = rsd[ev[k]]; }
#pragma unroll
      for (int k4 = 0; k4 < 4; ++k4) {
        *(int4*)(eo + 4 * k4) = make_int4(ev[4 * k4], ev[4 * k4 + 1], ev[4 * k4 + 2], ev[4 * k4 + 3]);
        *(float4*)(go + 4 * k4) = make_float4(bv[4 * k4], bv[4 * k4 + 1], bv[4 * k4 + 2], bv[4 * k4 + 3]);
        *(float4*)(so + 4 * k4) = make_float4(sdv[4 * k4], sdv[4 * k4 + 1], sdv[4 * k4 + 2], sdv[4 * k4 + 3]);
      }
    }
  }
}

typedef __attribute__((ext_vector_type(4))) float f32x4;
typedef __attribute__((ext_vector_type(2))) long lx2;
constexpr int DN_TOK = 16;
DI void down_issue(u32x4 (&W)[16], const u32* list, int b0, int n, const unsigned char* wd, int lane) {
  const int idx = min(b0 + (lane & 15), n - 1);
  const u32 ent = list[idx];
  const unsigned char* rp = wd + (size_t)(ent & 16383u) * 1024 + 16 * (lane >> 4);
#pragma unroll
  for (int s = 0; s < 16; ++s) W[s] = *(const u32x4*)(rp + 64 * s);
}
DI void down_proc(const u32x4 (&W)[16], const u32x4 (&Bf)[16], const u32* list, const float* xsc, float* dl, int b0, int n, int t0, int lane, u32* __restrict__ hgp) {
  f32x4 acc[4];
#pragma unroll
  for (int i = 0; i < 4; ++i) acc[i] = f32x4{0.f, 0.f, 0.f, 0.f};
#pragma unroll
  for (int s = 0; s < 16; ++s) {
    const lx2 av = __builtin_bit_cast(lx2, W[s]);
    const lx2 bv = __builtin_bit_cast(lx2, Bf[s]);
    acc[(2 * s) & 3] = __builtin_amdgcn_mfma_f32_16x16x32_fp8_fp8(av[0], bv[0], acc[(2 * s) & 3], 0, 0, 0);
    acc[(2 * s + 1) & 3] = __builtin_amdgcn_mfma_f32_16x16x32_fp8_fp8(av[1], bv[1], acc[(2 * s + 1) & 3], 0, 0, 0);
  }
  const f32x4 D = acc[0] + acc[1] + acc[2] + acc[3];
  const int c = lane & 15, g = lane >> 4;
#pragma unroll
  for (int i = 0; i < 4; ++i) dl[(4 * g + i) * 17 + c] = D[i];
  if (lane < 16) {
    const int idx = b0 + lane;
    const int ii = min(idx, n - 1);
    const u32 ent = list[ii];
    const float gl = __uint_as_float(list[2048 + ii]);
    const float sdl = __uint_as_float(list[4096 + ii]);
    const int tl = ent >> 21, k = (ent >> 14) & 127, e = ent & 16383;
    const float a = dl[lane * 17 + tl] * xsc[tl] * sdl;
    const float hgv = 0.5f * a * (1.f + erff(a * 0.70710678118654752f)) * gl;
    if (idx < n) hgp[(size_t)(t0 + tl) * 128 + k] = ((u32)e << 16) | (u32)f2bf(hgv);
  }
}
DI void peer_down_phase(const Params& p, unsigned char* smem, int layer, const bf16* __restrict__ x1b, u32* ctr) {
  unsigned char* ws = p.ws;
  const int* ex = (const int*)(ws + OFF_EX);
  const float* gt = (const float*)(ws + OFF_GT);
  const float* sd = (const float*)(ws + OFF_SD);
  u32* hgp = (u32*)(ws + OFF_HGP);
  const int tid = opaque_tid(), lane = tid & 63, w = tid >> 6;
  const unsigned char* wd = ws + OFF_WDOWN + (size_t)layer * 16384 * 1024;
  int* slot = (int*)smem;
  int* cnt = slot + 4;
  float* xsc = (float*)(smem + 64);
  unsigned char* xs8 = smem + 256;
  u32* list = (u32*)(smem + 256 + 16384);
  float* dl = (float*)(smem + 256 + 16384 + 24576) + w * 16 * 17;
  const u64 ltm = (lane == 0) ? 0ull : (~0ull >> (64 - lane));
  const int xcc16 = (int)xb_xcc_id();
  constexpr int NITEM = T_TOK / DN_TOK;
  __syncthreads();
  if (tid == 0) {
    unsigned* bar = (unsigned*)(ws + OFF_BAR);
    int nx = 0, xi = 0, nloc = 1;
    for (int j = 0; j < 16; ++j) { const unsigned cj = xb_ld(&bar[XB_XCNT(j)]); if (cj > 0u) { if (j == xcc16) { xi = nx; nloc = (int)cj; } ++nx; } }
    slot[0] = (int)atomicAdd(ctr + xcc16, 1u);
    slot[1] = nloc; slot[2] = xi; slot[3] = nx;
    *cnt = 0;
  }
  __syncthreads();
  const int rank = slot[0], nloc = slot[1], xi = slot[2], nx = slot[3];
  for (int slice = xi; slice < 8; slice += nx) {
    for (int item = rank; item < NITEM; item += nloc) {
      __syncthreads();
      const int t0 = item * DN_TOK;
      {
        const int row = tid >> 4, sgm = tid & 15;
        const bf16* xp = x1b + (size_t)(t0 + row) * 1024 + 64 * sgm;
        u32x4 v[8];
#pragma unroll
        for (int i = 0; i < 8; ++i) v[i] = *(const u32x4*)(xp + 8 * i);
        float am = 0.f;
#pragma unroll
        for (int i = 0; i < 8; ++i)
#pragma unroll
          for (int q = 0; q < 4; ++q) am = fmaxf(am, fmaxf(fabsf(bflo(v[i][q])), fabsf(bfhi(v[i][q]))));
        am = fmaxf(am, __shfl_xor(am, 8)); am = fmaxf(am, __shfl_xor(am, 4));
        am = fmaxf(am, __shfl_xor(am, 2)); am = fmaxf(am, __shfl_xor(am, 1));
        const float sc = am > 0.f ? 440.f / am : 1.f;
        if (sgm == 0) xsc[row] = am > 0.f ? am / 440.f : 1.f;
        u32x4* dp = (u32x4*)(xs8 + row * 1024 + 64 * sgm);
#pragma unroll
        for (int i2 = 0; i2 < 4; ++i2) {
          u32 pk[4];
#pragma unroll
          for (int h = 0; h < 2; ++h) {
            const u32x4 vv = v[2 * i2 + h];
            int t1 = __builtin_amdgcn_cvt_pk_fp8_f32(bflo(vv[0]) * sc, bfhi(vv[0]) * sc, 0, false);
            pk[2 * h] = (u32)__builtin_amdgcn_cvt_pk_fp8_f32(bflo(vv[1]) * sc, bfhi(vv[1]) * sc, t1, true);
            int t2 = __builtin_amdgcn_cvt_pk_fp8_f32(bflo(vv[2]) * sc, bfhi(vv[2]) * sc, 0, false);
            pk[2 * h + 1] = (u32)__builtin_amdgcn_cvt_pk_fp8_f32(bflo(vv[3]) * sc, bfhi(vv[3]) * sc, t2, true);
          }
          dp[i2] = u32x4{pk[0], pk[1], pk[2], pk[3]};
        }
      }
#pragma unroll
      for (int i = 0; i < 4; ++i) {
        const int tl = 4 * w + i;
        const size_t ro = (size_t)(t0 + tl) * 128 + lane;
        const int e_lo = ex[ro], e_hi = ex[ro + 64];
        const float g_lo = gt[ro], g_hi = gt[ro + 64], s_lo = sd[ro], s_hi = sd[ro + 64];
        const bool in_lo = (e_lo >> 11) == slice, in_hi = (e_hi >> 11) == slice;
        const u64 mlo = __ballot(in_lo), mhi = __ballot(in_hi);
        const int clo = __popcll(mlo), c = clo + __popcll(mhi);
        int base = 0;
        if (lane == 0) base = atomicAdd(cnt, c);
        base = __builtin_amdgcn_readfirstlane(base);
        if (in_lo) { int pos = base + __popcll(mlo & ltm); list[pos] = ((u32)tl << 21) | ((u32)lane << 14) | (u32)e_lo; list[2048 + pos] = __float_as_uint(g_lo); list[4096 + pos] = __float_as_uint(s_lo); }
        if (in_hi) { int pos = base + clo + __popcll(mhi & ltm); list[pos] = ((u32)tl << 21) | ((u32)(64 + lane) << 14) | (u32)e_hi; list[2048 + pos] = __float_as_uint(g_hi); list[4096 + pos] = __float_as_uint(s_hi); }
      }
      __syncthreads();
      const int n = *cnt;
      if (n > 0) {
        const int nb = (n + 15) >> 4;
        u32x4 Bf[16];
        {
          const unsigned char* bp = xs8 + (lane & 15) * 1024 + 16 * (lane >> 4);
#pragma unroll
          for (int s2 = 0; s2 < 16; ++s2) Bf[s2] = *(const u32x4*)(bp + 64 * s2);
        }
        u32x4 WA[16], WB[16];
        if (w < nb) down_issue(WA, list, 16 * w, n, wd, lane);
        for (int b = w; b < nb; b += 8) {
          down_issue(WB, list, 16 * (b + 4), n, wd, lane);
          __builtin_amdgcn_sched_barrier(0);
          down_proc(WA, Bf, list, xsc, dl, 16 * b, n, t0, lane, hgp);
          __builtin_amdgcn_sched_barrier(0);
          down_issue(WA, list, 16 * (b + 8), n, wd, lane);
          __builtin_amdgcn_sched_barrier(0);
          if (b + 4 < nb) down_proc(WB, Bf, list, xsc, dl, 16 * (b + 4), n, t0, lane, hgp);
          __builtin_amdgcn_sched_barrier(0);
        }
      }
      __syncthreads();
      if (tid == 0) *cnt = 0;
    }
  }
}

DI void xcc_census(unsigned char* ws, u32* rankctr, int* sl, int tid) {
  __syncthreads();
  if (tid == 0) {
    unsigned* bar = (unsigned*)(ws + OFF_BAR);
    const unsigned myx = xb_xcc_id();
    int nx = 0, xo = 0, nloc = 1;
    for (unsigned j = 0; j < 16; ++j) { const unsigned cj = xb_ld(&bar[XB_XCNT(j)]); if (cj > 0u) { if (j == myx) { xo = nx; nloc = (int)cj; } ++nx; } }
    sl[0] = (int)atomicAdd(rankctr + myx, 1u);
    sl[1] = nloc; sl[2] = xo; sl[3] = nx;
  }
  __syncthreads();
}

DI void dn2_issue(u32x4 (&W)[16], const int* pl, const unsigned char* wbase, int grp) {
#pragma unroll
  for (int j = 0; j < 16; ++j) W[j] = *(const u32x4*)(wbase + (size_t)pl[8 * j + grp] * 1024);
}
DI void dn2_math(const u32x4 (&W)[16], u32x4 x0, u32x4 x1, float* __restrict__ parow, int lane) {
  f2 xf[8];
#pragma unroll
  for (int q = 0; q < 4; ++q) { xf[q] = f2{bflo(x0[q]), bfhi(x0[q])}; xf[4 + q] = f2{bflo(x1[q]), bfhi(x1[q])}; }
  float pv[16];
#pragma unroll
  for (int j = 0; j < 16; ++j) {
    f2 s2 = {0.f, 0.f};
#pragma unroll
    for (int d = 0; d < 4; ++d) {
      f2 lo = __builtin_amdgcn_cvt_pk_f32_fp8((int)W[j][d], false);
      f2 hi = __builtin_amdgcn_cvt_pk_f32_fp8((int)W[j][d], true);
      s2 = lo * xf[2 * d] + s2;
      s2 = hi * xf[2 * d + 1] + s2;
    }
    pv[j] = s2.x + s2.y;
  }
  const bool b2 = lane & 4, b1 = lane & 2, b0 = lane & 1;
  float q8[8];
#pragma unroll
  for (int i = 0; i < 8; ++i) { float snd = b2 ? pv[i] : pv[i + 8]; float kp = b2 ? pv[i + 8] : pv[i]; q8[i] = kp + __shfl_xor(snd, 4); }
  float q4[4];
#pragma unroll
  for (int i = 0; i < 4; ++i) { float snd = b1 ? q8[i] : q8[i + 4]; float kp = b1 ? q8[i + 4] : q8[i]; q4[i] = kp + __shfl_xor(snd, 2); }
  float r2[2];
#pragma unroll
  for (int i = 0; i < 2; ++i) { float snd = b0 ? q4[i] : q4[i + 2]; float kp = b0 ? q4[i + 2] : q4[i]; r2[i] = kp + __shfl_xor(snd, 1); }
  const int j0 = (b0 ? 2 : 0) + (b1 ? 4 : 0) + (b2 ? 8 : 0);
  const int grp = lane >> 3;
  parow[8 * j0 + grp] = r2[0];
  parow[8 * (j0 + 1) + grp] = r2[1];
}
DI void peer_down2_phase(const Params& p, unsigned char* smem, int layer, const bf16* __restrict__ x1b, u32* ctr) {
  unsigned char* ws = p.ws;
  const int* ex = (const int*)(ws + OFF_EX);
  const unsigned char* wd = ws + OFF_WDOWN + (size_t)layer * 16384 * 1024;
  float* pa = (float*)(ws + OFF_YB);
  int* slot = (int*)smem;
  const int tid = opaque_tid(), lane = tid & 63, w = tid >> 6;
  const int grp = lane >> 3, c = lane & 7;
  int* pl = (int*)(smem + 256) + w * 2048;
  const int xcc = (int)xcc_id();
  xcc_census(ws, ctr + 8, slot + 4, tid);
  const bool stat = (slot[7] == 8);
  int it_next = slot[4];
  const int it_step = slot[5], xi = slot[6];
  for (int si = 0; si < (stat ? 1 : 8); ++si) {
    const int slice = stat ? xi : ((xcc + si) & 7);
    for (;;) {
      int item;
      if (stat) { item = it_next; it_next += it_step; }
      else {
        __syncthreads();
        if (tid == 0) *slot = (int)atomicAdd(ctr + slice, 1u);
        __syncthreads();
        item = *slot;
      }
      if (item >= 256) break;
      const int t0 = item * 64 + 16 * w;
      const unsigned char* wbase = wd + slice * 128 + c * 16;
      {
        const int* src = ex + (size_t)t0 * 128;
#pragma unroll
        for (int i = 0; i < 32; ++i) pl[i * 64 + lane] = src[i * 64 + lane];
      }
      const bf16* xb0 = x1b + (size_t)t0 * 1024 + slice * 128 + c * 16;
      float* pbase = pa + ((size_t)slice * T_TOK + t0) * 128;
      u32x4 WA[16], WB[16];
      u32x4 xa0, xa1, xb_0, xb_1;
      dn2_issue(WA, pl, wbase, grp);
      xa0 = *(const u32x4*)(xb0); xa1 = *(const u32x4*)(xb0 + 8);
      for (int tl = 0; tl < 16; tl += 2) {
        dn2_issue(WB, pl + (tl + 1) * 128, wbase, grp);
        xb_0 = *(const u32x4*)(xb0 + (size_t)(tl + 1) * 1024); xb_1 = *(const u32x4*)(xb0 + (size_t)(tl + 1) * 1024 + 8);
        __builtin_amdgcn_sched_barrier(0);
        dn2_math(WA, xa0, xa1, pbase + (size_t)tl * 128, lane);
        __builtin_amdgcn_sched_barrier(0);
        if (tl + 2 < 16) {
          dn2_issue(WA, pl + (tl + 2) * 128, wbase, grp);
          xa0 = *(const u32x4*)(xb0 + (size_t)(tl + 2) * 1024); xa1 = *(const u32x4*)(xb0 + (size_t)(tl + 2) * 1024 + 8);
        }
        __builtin_amdgcn_sched_barrier(0);
        dn2_math(WB, xb_0, xb_1, pbase + (size_t)(tl + 1) * 128, lane);
        __builtin_amdgcn_sched_barrier(0);
      }
    }
  }
}
DI void peer_hg_phase(const Params& p) {
  unsigned char* ws = p.ws;
  const int* ex = (const int*)(ws + OFF_EX);
  const float* gt = (const float*)(ws + OFF_GT);
  const float* sd = (const float*)(ws + OFF_SD);
  const float* pa = (const float*)(ws + OFF_YB);
  u32* hgp = (u32*)(ws + OFF_HGP);
  const int tid = opaque_tid();
  for (size_t i = (size_t)blockIdx.x * 256 + tid; i < (size_t)T_TOK * 128; i += (size_t)gridDim.x * 256) {
    float a = 0.f;
#pragma unroll
    for (int s2 = 0; s2 < 8; ++s2) a += pa[(size_t)s2 * T_TOK * 128 + i];
    a *= sd[i];
    const float hgv = 0.5f * a * (1.f + erff(a * 0.70710678118654752f)) * gt[i];
    hgp[i] = ((u32)ex[i] << 16) | (u32)f2bf(hgv);
  }
}

DI void up_issue(u32x4 (&W)[16], u32 (&pj)[16], const u32* pl, const unsigned char* wbase, int grp) {
#pragma unroll
  for (int j = 0; j < 16; ++j) {
    pj[j] = pl[8 * j + grp];
    W[j] = *(const u32x4*)(wbase + (size_t)(pj[j] >> 16) * 1024);
  }
}
DI void up_math(const u32x4 (&W)[16], const u32 (&pj)[16], float* __restrict__ yrow, int lane) {
  f2 y[8];
#pragma unroll
  for (int i = 0; i < 8; ++i) y[i] = f2{0.f, 0.f};
#pragma unroll
  for (int j = 0; j < 16; ++j) {
    const float h = __uint_as_float(pj[j] << 16);
    const f2 hh = {h, h};
#pragma unroll
    for (int d = 0; d < 4; ++d) {
      f2 lo = __builtin_amdgcn_cvt_pk_f32_fp8((int)W[j][d], false);
      f2 hi = __builtin_amdgcn_cvt_pk_f32_fp8((int)W[j][d], true);
      y[2 * d] = lo * hh + y[2 * d];
      y[2 * d + 1] = hi * hh + y[2 * d + 1];
    }
  }
  const bool b5 = lane & 32, b4 = lane & 16, b3 = lane & 8;
  f2 q4[4];
#pragma unroll
  for (int i = 0; i < 4; ++i) {
    f2 snd = b5 ? y[i] : y[i + 4]; f2 kp = b5 ? y[i + 4] : y[i];
    q4[i] = f2{kp.x + __shfl_xor(snd.x, 32), kp.y + __shfl_xor(snd.y, 32)};
  }
  f2 r2[2];
#pragma unroll
  for (int i = 0; i < 2; ++i) {
    f2 snd = b4 ? q4[i] : q4[i + 2]; f2 kp = b4 ? q4[i + 2] : q4[i];
    r2[i] = f2{kp.x + __shfl_xor(snd.x, 16), kp.y + __shfl_xor(snd.y, 16)};
  }
  f2 a;
  { f2 snd = b3 ? r2[0] : r2[1]; f2 kp = b3 ? r2[1] : r2[0]; a = f2{kp.x + __shfl_xor(snd.x, 8), kp.y + __shfl_xor(snd.y, 8)}; }
  const int ci = (b5 ? 4 : 0) + (b4 ? 2 : 0) + (b3 ? 1 : 0);
  *(float2*)(yrow + (lane & 7) * 16 + 2 * ci) = make_float2(a.x, a.y);
}
DI void peer_up_phase(const Params& p, unsigned char* smem, int layer, u32* ctr) {
  unsigned char* ws = p.ws;
  const u32* hgp = (const u32*)(ws + OFF_HGP);
  const unsigned char* wu = ws + OFF_WUP + (size_t)layer * 16384 * 1024;
  float* yb = (float*)(ws + OFF_YB);
  int* slot = (int*)smem;
  const int tid = opaque_tid(), lane = tid & 63, w = tid >> 6;
  const int grp = lane >> 3, c = lane & 7;
  u32* pl = (u32*)(smem + 256) + w * 2048;
  const int xcc = (int)xcc_id();
  xcc_census(ws, ctr + 8, slot + 4, tid);
  const bool stat = (slot[7] == 8);
  int it_next = slot[4];
  const int it_step = slot[5], xi = slot[6];
  for (int si = 0; si < (stat ? 1 : 8); ++si) {
    const int slice = stat ? xi : ((xcc + si) & 7);
    for (;;) {
      int item;
      if (stat) { item = it_next; it_next += it_step; }
      else {
        __syncthreads();
        if (tid == 0) *slot = (int)atomicAdd(ctr + slice, 1u);
        __syncthreads();
        item = *slot;
      }
      if (item >= 256) break;
      const int t0 = item * 64 + 16 * w;
      const unsigned char* wbase = wu + slice * 128 + c * 16;
      {
        const u32* src = hgp + (size_t)t0 * 128;
#pragma unroll
        for (int i = 0; i < 32; ++i) pl[i * 64 + lane] = src[i * 64 + lane];
      }
      float* ybase = yb + (size_t)t0 * 1024 + slice * 128;
      u32x4 WA[16], WB[16];
      u32 pA[16], pB[16];
      up_issue(WA, pA, pl, wbase, grp);
      for (int tl = 0; tl < 16; tl += 2) {
        up_issue(WB, pB, pl + (tl + 1) * 128, wbase, grp);
        __builtin_amdgcn_sched_barrier(0);
        up_math(WA, pA, ybase + (size_t)tl * 1024, lane);
        __builtin_amdgcn_sched_barrier(0);
        if (tl + 2 < 16) up_issue(WA, pA, pl + (tl + 2) * 128, wbase, grp);
        __builtin_amdgcn_sched_barrier(0);
        up_math(WB, pB, ybase + (size_t)(tl + 1) * 1024, lane);
        __builtin_amdgcn_sched_barrier(0);
      }
    }
  }
}

__global__ void __launch_bounds__(256, 2) fwd_megakernel(Params p) {
  cg::grid_group grid = cg::this_grid();
  __shared__ __attribute__((aligned(16))) unsigned char smem[SMEM_BYTES];
  unsigned char* ws = p.ws;
  __shared__ __attribute__((aligned(16))) unsigned xb_words[4];
  if (threadIdx.x < 4) xb_words[threadIdx.x] = 0u;
  __syncthreads();
  XcdBarrier gbar = xcd_barrier_post((unsigned*)(ws + OFF_BAR), (volatile LAS unsigned*)&xb_words);
  bf16* xb = (bf16*)(ws + OFF_XB);
  bf16* x1b = (bf16*)(ws + OFF_VT);
  float* x1f = p.out;
  bf16* x2b = (bf16*)(ws + OFF_X2F);
  float* mbuf = (float*)(ws + OFF_M);
  bf16* hb = (bf16*)(ws + OFF_HB);
  float* ybuf = (float*)(ws + OFF_YB);
  u32* ctrs = (u32*)(ws + OFF_CTR);

  RUN(0, prep_phase(p, smem))
  if (p.ws == nullptr) grid.sync();
  xcd_barrier(gbar);
  RUN(1, gemm_phase<EPI_MLA_IN>(p, smem, xb, 1024, (const bf16*)(ws + OFF_WIN_T), 1024, 6, 0))
  xcd_barrier(gbar);
  RUN(2, gemm_phase<EPI_MLA_Q>(p, smem, hb, 640, (const bf16*)(ws + OFF_WUQ_T), 384, 12, 0))
  RUN(3, gemm_phase<EPI_MLA_KV>(p, smem, hb + 384, 640, (const bf16*)(ws + OFF_WUKV_T), 256, 16, 0))
  xcd_barrier(gbar);
  for (int pass = 0; pass < 2; ++pass) {
    const bool conv_first = blockIdx.x >= (gridDim.x >> 1);
    if ((pass == 0) == conv_first) {
      fp8_rows(p.peer_w_down, ws + OFF_WDOWN, (float*)(ws + OFF_RSD), 32768);
      fp8_rows(p.peer_w_up, ws + OFF_WUP, (float*)(ws + OFF_RSU), 32768);
    } else {
      RUN(4, attn_phase<192, false>(p, smem, 0.07216878364870322f * 1.4426950408889634f))
    }
  }
  xcd_barrier(gbar);
  RUN(5, gemm_phase<EPI_F32>(p, smem, xb, 1024, (const bf16*)(ws + OFF_WO_T), 1024, 8, 0))
#ifdef HOTEXP
  xcd_barrier(gbar);
  gemm_phase<EPI_F32, HOTEXP>(p, smem, xb, 1024, (const bf16*)(ws + OFF_WO_T), 1024, 8, 0);
#endif
  xcd_barrier(gbar);
  RUN(6, ln1_phase<float>(p, p.x, mbuf, p.ln_gain, p.ln_bias, nullptr, x1b))
  xcd_barrier(gbar);
  RUN(7, peer1_phase(p, smem, x1b, (const bf16*)(ws + OFF_WQ_T), 0))
  xcd_barrier(gbar);
  RUN(8, peer_down2_phase(p, smem, 0, x1b, ctrs))
  xcd_barrier(gbar);
  peer_hg_phase(p);
#ifdef REP_DOWN
  xcd_barrier(gbar);
  peer_down2_phase(p, smem, 0, x1b, ctrs + 160);
#endif
  xcd_barrier(gbar);
  RUN(16, peer_up_phase(p, smem, 0, ctrs + 32))
#ifdef REP_UP
  xcd_barrier(gbar);
  peer_up_phase(p, smem, 0, ctrs + 192);
#endif
  xcd_barrier(gbar);
  RUN(17, ln1_phase<bf16>(p, x1b, ybuf, p.ln_gain + 1024, p.ln_bias + 1024, nullptr, x2b))
  xcd_barrier(gbar);
  RUN(9, gemm_phase<EPI_DSA_IN>(p, smem, x2b, 1024, (const bf16*)(ws + OFF_DIN_T), 1024, 29, 1))
  xcd_barrier(gbar);
  RUN(10, indexer_phase(p, smem))
  xcd_barrier(gbar);
  RUN(11, attn_phase<128, true>(p, smem, 0.08838834764831845f * 1.4426950408889634f))
  xcd_barrier(gbar);
  RUN(12, gemm_phase<EPI_F32>(p, smem, xb, 1024, (const bf16*)(ws + OFF_DO_T), 1024, 8, 1))
  xcd_barrier(gbar);
  RUN(13, ln1_phase<bf16>(p, x2b, mbuf, p.ln_gain + 2048, p.ln_bias + 2048, nullptr, x1b))
  xcd_barrier(gbar);
  RUN(14, peer1_phase(p, smem, x1b, (const bf16*)(ws + OFF_WQ_T) + (size_t)2048 * 1024, 1))
  xcd_barrier(gbar);
  RUN(15, peer_down2_phase(p, smem, 1, x1b, ctrs + 64))
  xcd_barrier(gbar);
  peer_hg_phase(p);
  xcd_barrier(gbar);
  RUN(18, peer_up_phase(p, smem, 1, ctrs + 96))
  xcd_barrier(gbar);
  RUN(19, ln1_phase<bf16>(p, x1b, ybuf, p.ln_gain + 3072, p.ln_bias + 3072, p.out, nullptr))
}

extern "C" void kernel_launch(void* const* d_in, const int* in_sizes, int n_in, void* d_out, int out_size, void* d_ws, size_t ws_size,
                              hipStream_t stream) {
  static int grid_blocks = 0;
  if (!grid_blocks) {
    int dev = 0, cus = 0, per_cu = 0;
    (void)hipGetDevice(&dev);
    (void)hipDeviceGetAttribute(&cus, hipDeviceAttributeMultiprocessorCount, dev);
    (void)hipOccupancyMaxActiveBlocksPerMultiprocessor(&per_cu, fwd_megakernel, 256, 0);
    if (per_cu > 2) per_cu = 2;
    if (per_cu < 1) per_cu = 1;
    grid_blocks = cus * per_cu;
  }
  Params p;
  memset(&p, 0, sizeof(p));
  p.x = (const float*)d_in[0];
  p.mla_w_in = (const float*)d_in[1];
  p.mla_q_norm = (const float*)d_in[2];
  p.mla_kv_norm = (const float*)d_in[3];
  p.mla_w_uq = (const float*)d_in[4];
  p.mla_w_ukv = (const float*)d_in[5];
  p.mla_w_o = (const float*)d_in[6];
  p.dsa_w_in = (const float*)d_in[7];
  p.dsa_w_o = (const float*)d_in[8];
  p.peer_w_q = (const float*)d_in[9];
  p.peer_sub_keys = (const float*)d_in[10];
  p.peer_w_down = (const float*)d_in[11];
  p.peer_w_up = (const float*)d_in[12];
  p.ln_gain = (const float*)d_in[13];
  p.ln_bias = (const float*)d_in[14];
  p.out = (float*)d_out;
  p.ws = (unsigned char*)d_ws;
  for (int i = 0; i < 32; ++i) p.inv64[i] = powf(10000.0f, -((float)(2 * i) / 64.0f));
  for (int i = 0; i < 64; ++i) p.inv128[i] = powf(10000.0f, -((float)(2 * i) / 128.0f));
  (void)hipMemsetAsync((unsigned char*)d_ws + OFF_BAR, 0, XCD_BAR_WORDS * 4, stream);
  void* args[] = {&p};
  hipError_t e = hipLaunchCooperativeKernel((void*)fwd_megakernel, dim3(grid_blocks), dim3(256), args, 0, stream);
  if (e != hipSuccess) fprintf(stderr, "cooperative launch failed: %s (grid %d)\n", hipGetErrorString(e), grid_blocks);
}
```
